# Optimizing an MI355X kernel written in HIP

```python
import math
import jax, jax.numpy as jnp
from jax import lax
import numpy as np

D_MODEL = 2048
BATCH = 4
SEQ = 2048
DEPTH = 1

ATTN_WIDTH = D_MODEL // 2
REC_WIDTH = D_MODEL // 2
N_ATTN_HEADS = 8
ATTN_HEAD_DIM = ATTN_WIDTH // N_ATTN_HEADS
QK_DIM = ATTN_HEAD_DIM // 2
N_REC_BLOCKS = 8
REC_BLOCK = REC_WIDTH // N_REC_BLOCKS
CONV_WIDTH = 4
LRU_C = 8.0
ROPE_THETA = 10000.0
Q_BLOCK = 128
NORM_EPS = 1e-6
IN_WIDTH = 4 * ATTN_WIDTH + 2 * REC_WIDTH
SPLITS = [ATTN_WIDTH, 2 * ATTN_WIDTH, 3 * ATTN_WIDTH, 4 * ATTN_WIDTH, 4 * ATTN_WIDTH + REC_WIDTH]

kernel_name = "hymba_diffattn_rglru_hybrid"


def rms_norm(x, g):
    xf = x.astype(jnp.float32)
    y = xf * lax.rsqrt(jnp.mean(xf * xf, axis=-1, keepdims=True) + NORM_EPS)
    return (y * g.astype(jnp.float32)).astype(x.dtype)


def rope(t, cos, sin):
    tf = t.astype(jnp.float32)
    t1, t2 = jnp.split(tf, 2, axis=-1)
    out = jnp.concatenate([t1 * cos - t2 * sin, t2 * cos + t1 * sin], axis=-1)
    return out.astype(t.dtype)


def diff_attention(q, k, v, lam):
    seq = q.shape[1]
    q = q.transpose(0, 2, 3, 1, 4)
    k = k.transpose(0, 2, 3, 1, 4)
    v = v.transpose(0, 2, 1, 3)
    scale = QK_DIM ** -0.5
    outs = []
    for s0 in range(0, seq, Q_BLOCK):
        end = s0 + Q_BLOCK
        qb = q[:, :, :, s0:end]
        kb = k[:, :, :, :end]
        vb = v[:, :, :end]
        s = jnp.einsum('bhmqd,bhmkd->bhmqk', qb, kb).astype(jnp.float32) * scale
        mask = jnp.arange(end)[None, :] <= (s0 + jnp.arange(Q_BLOCK))[:, None]
        s = jnp.where(mask, s, -jnp.inf)
        p = jax.nn.softmax(s, axis=-1)
        w = p[:, :, 0] - lam * p[:, :, 1]
        outs.append(jnp.einsum('bhqk,bhkd->bhqd', w.astype(vb.dtype), vb))
    o = jnp.concatenate(outs, axis=2)
    return o.transpose(0, 2, 1, 3)


def causal_conv(x, w, b):
    c = x.shape[-1]
    y = lax.conv_general_dilated(
        x, w[:, None, :].astype(x.dtype), window_strides=(1,),
        padding=[(CONV_WIDTH - 1, 0)], dimension_numbers=('NWC', 'WIO', 'NWC'),
        feature_group_count=c)
    return y + b.astype(x.dtype)


def rg_lru(x, w_a, b_a, w_x, b_x, lru_lambda):
    bsz, seq, c = x.shape
    xb = x.reshape(bsz, seq, N_REC_BLOCKS, REC_BLOCK)
    r = jax.nn.sigmoid(jnp.einsum('bsni,nij->bsnj', xb, w_a).reshape(bsz, seq, c).astype(jnp.float32)
                       + b_a.astype(jnp.float32))
    i = jax.nn.sigmoid(jnp.einsum('bsni,nij->bsnj', xb, w_x).reshape(bsz, seq, c).astype(jnp.float32)
                       + b_x.astype(jnp.float32))
    log_a = -LRU_C * r * jax.nn.softplus(-lru_lambda.astype(jnp.float32))
    a = jnp.exp(log_a)
    mult = jnp.sqrt(-jnp.expm1(2.0 * log_a))
    u = mult * (i * x.astype(jnp.float32))

    def combine(left, right):
        a_l, u_l = left
        a_r, u_r = right
        return a_l * a_r, a_r * u_l + u_r

    _, h = lax.associative_scan(combine, (a, u), axis=1)
    return h.astype(x.dtype)


def setup_inputs(seed: int = 0) -> dict:
    key = jax.random.key(seed)
    ks = jax.random.split(key, 20)
    f32 = jnp.float32
    x = jax.random.normal(ks[0], (BATCH, SEQ, D_MODEL), f32)
    positions = (jnp.arange(SEQ, dtype=jnp.int32)[None, :]
                 + jax.random.randint(ks[1], (BATCH, 1), 0, 1024, dtype=jnp.int32))
    norm_gain = 1.0 + 0.02 * jax.random.normal(ks[2], (DEPTH, D_MODEL), f32)
    w_in = jax.random.normal(ks[3], (DEPTH, D_MODEL, IN_WIDTH), f32) * D_MODEL ** -0.5
    lambda_q1 = 0.1 * jax.random.normal(ks[4], (DEPTH, QK_DIM), f32)
    lambda_k1 = 0.1 * jax.random.normal(ks[5], (DEPTH, QK_DIM), f32)
    lambda_q2 = 0.1 * jax.random.normal(ks[6], (DEPTH, QK_DIM), f32)
    lambda_k2 = 0.1 * jax.random.normal(ks[7], (DEPTH, QK_DIM), f32)
    subln_gain = 1.0 + 0.02 * jax.random.normal(ks[8], (DEPTH, ATTN_HEAD_DIM), f32)
    conv_w = jax.random.normal(ks[9], (DEPTH, CONV_WIDTH, REC_WIDTH), f32) * CONV_WIDTH ** -0.5
    conv_b = 0.01 * jax.random.normal(ks[10], (DEPTH, REC_WIDTH), f32)
    w_a = jax.random.normal(ks[11], (DEPTH, N_REC_BLOCKS, REC_BLOCK, REC_BLOCK), f32) * REC_BLOCK ** -0.5
    b_a = 0.01 * jax.random.normal(ks[12], (DEPTH, REC_WIDTH), f32)
    w_x = jax.random.normal(ks[13], (DEPTH, N_REC_BLOCKS, REC_BLOCK, REC_BLOCK), f32) * REC_BLOCK ** -0.5
    b_x = 0.01 * jax.random.normal(ks[14], (DEPTH, REC_WIDTH), f32)
    a_c = jax.random.uniform(ks[15], (DEPTH, REC_WIDTH), f32, 0.9, 0.999)
    a_base = a_c ** (1.0 / LRU_C)
    lru_lambda = jnp.log(a_base) - jnp.log1p(-a_base)
    w_out = jax.random.normal(ks[16], (DEPTH, ATTN_WIDTH + REC_WIDTH, D_MODEL), f32) * (ATTN_WIDTH + REC_WIDTH) ** -0.5
    final_gain = 1.0 + 0.02 * jax.random.normal(ks[17], (D_MODEL,), f32)
    return {"x": x, "positions": positions, "norm_gain": norm_gain, "w_in": w_in,
            "lambda_q1": lambda_q1, "lambda_k1": lambda_k1, "lambda_q2": lambda_q2,
            "lambda_k2": lambda_k2, "subln_gain": subln_gain, "conv_w": conv_w,
            "conv_b": conv_b, "w_a": w_a, "b_a": b_a, "w_x": w_x, "b_x": b_x,
            "lru_lambda": lru_lambda, "w_out": w_out, "final_gain": final_gain}


def reference(x, positions, norm_gain, w_in, lambda_q1, lambda_k1, lambda_q2, lambda_k2,
              subln_gain, conv_w, conv_b, w_a, b_a, w_x, b_x, lru_lambda, w_out, final_gain):
    bsz, seq, _ = x.shape
    inv_freq = ROPE_THETA ** (-jnp.arange(0, QK_DIM, 2, dtype=jnp.float32) / QK_DIM)
    ang = positions.astype(jnp.float32)[..., None] * inv_freq
    cos = jnp.cos(ang)[:, :, None, None, :]
    sin = jnp.sin(ang)[:, :, None, None, :]
    for l in range(DEPTH):
        h = rms_norm(x, norm_gain[l])
        proj = h @ w_in[l]
        q, k, v, g_attn, xr, g_rec = jnp.split(proj, SPLITS, axis=-1)
        q = rope(q.reshape(bsz, seq, N_ATTN_HEADS, 2, QK_DIM), cos, sin)
        k = rope(k.reshape(bsz, seq, N_ATTN_HEADS, 2, QK_DIM), cos, sin)
        v = v.reshape(bsz, seq, N_ATTN_HEADS, ATTN_HEAD_DIM)
        lam_init = 0.8 - 0.6 * math.exp(-0.3 * l)
        lam = (jnp.exp(jnp.sum(lambda_q1[l].astype(jnp.float32) * lambda_k1[l].astype(jnp.float32)))
               - jnp.exp(jnp.sum(lambda_q2[l].astype(jnp.float32) * lambda_k2[l].astype(jnp.float32)))
               + lam_init)
        o = diff_attention(q, k, v, lam)
        o = rms_norm(o, subln_gain[l]) * (1.0 - lam_init)
        o = o.reshape(bsz, seq, ATTN_WIDTH) * jax.nn.silu(g_attn)
        r = causal_conv(xr, conv_w[l], conv_b[l])
        r = rg_lru(r, w_a[l], b_a[l], w_x[l], b_x[l], lru_lambda[l])
        r = r * jax.nn.silu(g_rec)
        mix = jnp.concatenate([o, r], axis=-1)
        x = x + mix @ w_out[l]
    return rms_norm(x, final_gain)
```

```cpp
#include <hip/hip_runtime.h>
#include <cstdio>
#include <cstdint>
#include <cmath>

constexpr int BATCH = 4, SEQ = 2048, DM = 2048, M = BATCH * SEQ;
constexpr int AW = 1024, RW = 1024, NH = 8, HD = 128, QK = 64, NRB = 8, RB = 128, CW = 4;
constexpr int INW = 6144;
constexpr int C_Q = 0, C_K = 1024, C_V = 2048, C_GA = 3072, C_XR = 4096, C_GR = 5120;
constexpr float EPS = 1e-6f, LRU_C = 8.0f;

__device__ __forceinline__ float block_sum256(float v, float* red) {
    for (int o = 32; o > 0; o >>= 1) v += __shfl_xor(v, o);
    const int w = threadIdx.x >> 6, l = threadIdx.x & 63;
    __syncthreads();
    if (l == 0) red[w] = v;
    __syncthreads();
    return red[0] + red[1] + red[2] + red[3];
}

__global__ void __launch_bounds__(256) k_rmsnorm(const float* __restrict__ a, const float* __restrict__ b, const float* __restrict__ g, float* __restrict__ out) {
    __shared__ float red[4];
    const int row = blockIdx.x;
    float v[8]; float s = 0.f;
#pragma unroll
    for (int i = 0; i < 8; ++i) { const int c = threadIdx.x + 256 * i; float x = a[(size_t)row * DM + c]; if (b) x += b[(size_t)row * DM + c]; v[i] = x; s += x * x; }
    const float tot = block_sum256(s, red);
    const float rs = 1.0f / sqrtf(tot / DM + EPS);
#pragma unroll
    for (int i = 0; i < 8; ++i) { const int c = threadIdx.x + 256 * i; out[(size_t)row * DM + c] = v[i] * rs * g[c]; }
}

__global__ void __launch_bounds__(256) k_gemm(const float* __restrict__ A, const float* __restrict__ B, float* __restrict__ C, int Mm, int Nn, int Kk) {
    __shared__ float As[16][68];
    __shared__ float Bs[16][68];
    const int tx = threadIdx.x & 15, ty = threadIdx.x >> 4;
    const int m0 = blockIdx.y * 64, n0 = blockIdx.x * 64;
    float acc[4][4] = {};
    for (int k0 = 0; k0 < Kk; k0 += 16) {
        {
            const int r = threadIdx.x >> 2, kk = (threadIdx.x & 3) * 4;
            const float4 a = *(const float4*)(A + (size_t)(m0 + r) * Kk + k0 + kk);
            As[kk + 0][r] = a.x; As[kk + 1][r] = a.y; As[kk + 2][r] = a.z; As[kk + 3][r] = a.w;
            const int kr = threadIdx.x >> 4, nn = (threadIdx.x & 15) * 4;
            const float4 bv = *(const float4*)(B + (size_t)(k0 + kr) * Nn + n0 + nn);
            *(float4*)&Bs[kr][nn] = bv;
        }
        __syncthreads();
#pragma unroll
        for (int k = 0; k < 16; ++k) {
            const float4 a = *(const float4*)&As[k][ty * 4];
            const float4 b = *(const float4*)&Bs[k][tx * 4];
            const float av[4] = {a.x, a.y, a.z, a.w}, bv[4] = {b.x, b.y, b.z, b.w};
#pragma unroll
            for (int i = 0; i < 4; ++i)
#pragma unroll
                for (int j = 0; j < 4; ++j) acc[i][j] = fmaf(av[i], bv[j], acc[i][j]);
        }
        __syncthreads();
    }
    for (int i = 0; i < 4; ++i) *(float4*)(C + (size_t)(m0 + ty * 4 + i) * Nn + n0 + tx * 4) = make_float4(acc[i][0], acc[i][1], acc[i][2], acc[i][3]);
}

__global__ void __launch_bounds__(256) k_rope(float* __restrict__ proj, const int* __restrict__ pos) {
    const int row = blockIdx.x;
    const float p = (float)pos[row];
    for (int i = threadIdx.x; i < 2 * NH * 2 * 32; i += 256) {
        const int j = i & 31, grp = i >> 5;
        const float inv_freq = powf(10000.0f, -(float)(2 * j) / 64.0f);
        const float ang = p * inv_freq;
        const float c = cosf(ang), s = sinf(ang);
        float* base = proj + (size_t)row * INW + grp * 64;
        const float t1 = base[j], t2 = base[j + 32];
        base[j] = t1 * c - t2 * s; base[j + 32] = t2 * c + t1 * s;
    }
}

__device__ __forceinline__ float silu_f(float x) { return x / (1.0f + expf(-x)); }
__device__ __forceinline__ float sigmoid_f(float x) { return 1.0f / (1.0f + expf(-x)); }

__global__ void __launch_bounds__(256) k_attn(const float* __restrict__ proj, const float* __restrict__ lq1, const float* __restrict__ lk1,
                                              const float* __restrict__ lq2, const float* __restrict__ lk2, const float* __restrict__ subln,
                                              float* __restrict__ mix) {
    __shared__ float ps[4][2][64];
    __shared__ float qs[4][128];
    const int wid = threadIdx.x >> 6, lane = threadIdx.x & 63;
    const int task = blockIdx.x * 4 + wid;
    const int row = task / NH, h = task % NH;
    const int b = row / SEQ, s = row % SEQ;
    float a1 = lq1[lane] * lk1[lane], a2 = lq2[lane] * lk2[lane];
    for (int o = 32; o > 0; o >>= 1) { a1 += __shfl_xor(a1, o); a2 += __shfl_xor(a2, o); }
    const float lam_init = 0.8f - 0.6f * expf(-0.3f * 0.0f);
    const float lam = expf(a1) - expf(a2) + lam_init;
    const float* qrow = proj + (size_t)row * INW + C_Q + h * 128;
    qs[wid][lane] = qrow[lane]; qs[wid][64 + lane] = qrow[64 + lane];
    __builtin_amdgcn_wave_barrier();
    const float* q0 = &qs[wid][0]; const float* q1 = &qs[wid][64];
    const float scale = 0.125f;
    float m0 = -INFINITY, m1 = -INFINITY;
    for (int k0 = 0; k0 <= s; k0 += 64) {
        const int k = k0 + lane;
        if (k <= s) {
            const float* krow = proj + (size_t)(b * SEQ + k) * INW + C_K + h * 128;
            float s0 = 0.f, s1 = 0.f;
            for (int d = 0; d < 64; d += 4) { const float4 ka = *(const float4*)(krow + d), kb = *(const float4*)(krow + 64 + d);
                s0 = fmaf(q0[d], ka.x, s0); s0 = fmaf(q0[d + 1], ka.y, s0); s0 = fmaf(q0[d + 2], ka.z, s0); s0 = fmaf(q0[d + 3], ka.w, s0);
                s1 = fmaf(q1[d], kb.x, s1); s1 = fmaf(q1[d + 1], kb.y, s1); s1 = fmaf(q1[d + 2], kb.z, s1); s1 = fmaf(q1[d + 3], kb.w, s1); }
            m0 = fmaxf(m0, s0 * scale); m1 = fmaxf(m1, s1 * scale);
        }
    }
    for (int o = 32; o > 0; o >>= 1) { m0 = fmaxf(m0, __shfl_xor(m0, o)); m1 = fmaxf(m1, __shfl_xor(m1, o)); }
    float l0 = 0.f, l1 = 0.f, o0a = 0.f, o0b = 0.f, o1a = 0.f, o1b = 0.f;
    for (int k0 = 0; k0 <= s; k0 += 64) {
        const int k = k0 + lane;
        float p0 = 0.f, p1 = 0.f;
        if (k <= s) {
            const float* krow = proj + (size_t)(b * SEQ + k) * INW + C_K + h * 128;
            float s0 = 0.f, s1 = 0.f;
            for (int d = 0; d < 64; d += 4) { const float4 ka = *(const float4*)(krow + d), kb = *(const float4*)(krow + 64 + d);
                s0 = fmaf(q0[d], ka.x, s0); s0 = fmaf(q0[d + 1], ka.y, s0); s0 = fmaf(q0[d + 2], ka.z, s0); s0 = fmaf(q0[d + 3], ka.w, s0);
                s1 = fmaf(q1[d], kb.x, s1); s1 = fmaf(q1[d + 1], kb.y, s1); s1 = fmaf(q1[d + 2], kb.z, s1); s1 = fmaf(q1[d + 3], kb.w, s1); }
            p0 = expf(s0 * scale - m0); p1 = expf(s1 * scale - m1);
        }
        l0 += p0; l1 += p1;
        ps[wid][0][lane] = p0; ps[wid][1][lane] = p1;
        __builtin_amdgcn_wave_barrier();
        const int kmax = (s - k0 + 1) < 64 ? (s - k0 + 1) : 64;
        for (int j = 0; j < kmax; ++j) {
            const float* vrow = proj + (size_t)(b * SEQ + k0 + j) * INW + C_V + h * 128;
            const float va = vrow[lane], vb = vrow[64 + lane];
            const float w0 = ps[wid][0][j], w1 = ps[wid][1][j];
            o0a = fmaf(w0, va, o0a); o0b = fmaf(w0, vb, o0b); o1a = fmaf(w1, va, o1a); o1b = fmaf(w1, vb, o1b);
        }
        __builtin_amdgcn_wave_barrier();
    }
    for (int o = 32; o > 0; o >>= 1) { l0 += __shfl_xor(l0, o); l1 += __shfl_xor(l1, o); }
    const float oa = o0a / l0 - lam * (o1a / l1), ob = o0b / l0 - lam * (o1b / l1);
    float ss = oa * oa + ob * ob;
    for (int o = 32; o > 0; o >>= 1) ss += __shfl_xor(ss, o);
    const float rs = 1.0f / sqrtf(ss / 128.0f + EPS);
    const float* grow = proj + (size_t)row * INW + C_GA + h * 128;
    float* mrow = mix + (size_t)row * (AW + RW) + h * 128;
    mrow[lane] = oa * rs * subln[lane] * (1.0f - lam_init) * silu_f(grow[lane]);
    mrow[64 + lane] = ob * rs * subln[64 + lane] * (1.0f - lam_init) * silu_f(grow[64 + lane]);
}

__global__ void __launch_bounds__(256) k_conv(const float* __restrict__ proj, const float* __restrict__ cw, const float* __restrict__ cb, float* __restrict__ y) {
    const int row = blockIdx.x, s = row % SEQ;
    for (int c = threadIdx.x; c < RW; c += 256) {
        float acc = cb[c];
        for (int j = 0; j < CW; ++j) { const int t = s - 3 + j; if (t >= 0) acc = fmaf(cw[j * RW + c], proj[(size_t)(row - 3 + j) * INW + C_XR + c], acc); }
        y[(size_t)row * RW + c] = acc;
    }
}
__global__ void __launch_bounds__(256) k_gates(const float* y, const float* __restrict__ wa, const float* __restrict__ ba, const float* __restrict__ wx,
                                               const float* __restrict__ bx, const float* __restrict__ lam, float* __restrict__ aout, float* uout) {
    __shared__ float ys[RW];
    const int row = blockIdx.x;
    for (int c = threadIdx.x; c < RW; c += 256) ys[c] = y[(size_t)row * RW + c];
    __syncthreads();
    for (int c = threadIdx.x; c < RW; c += 256) {
        const int n = c / RB, j = c % RB;
        float ga = 0.f, gx = 0.f;
        for (int i = 0; i < RB; ++i) { const float yi = ys[n * RB + i]; ga = fmaf(yi, wa[((size_t)n * RB + i) * RB + j], ga); gx = fmaf(yi, wx[((size_t)n * RB + i) * RB + j], gx); }
        const float r = sigmoid_f(ga + ba[c]), ig = sigmoid_f(gx + bx[c]);
        const float L = lam[c];
        const float sp = (-L > 20.f) ? -L : log1pf(expf(-L));
        const float log_a = -LRU_C * r * sp;
        const float a = expf(log_a);
        const float mult = sqrtf(-expm1f(2.0f * log_a));
        aout[(size_t)row * RW + c] = a;
        uout[(size_t)row * RW + c] = mult * (ig * ys[c]);
    }
}
__global__ void __launch_bounds__(256) k_scan(const float* __restrict__ a, const float* __restrict__ u, const float* __restrict__ proj, float* __restrict__ mix) {
    const int idx = blockIdx.x * 256 + threadIdx.x;
    const int b = idx / RW, c = idx % RW;
    float h = 0.f;
    for (int s = 0; s < SEQ; ++s) {
        const size_t row = (size_t)b * SEQ + s;
        h = fmaf(a[row * RW + c], h, u[row * RW + c]);
        mix[row * (AW + RW) + AW + c] = h * silu_f(proj[row * INW + C_GR + c]);
    }
}

extern "C" void kernel_launch(void* const* d_in, const int* in_sizes, int n_in, void* d_out, int out_size, void* d_ws, size_t ws_size, hipStream_t stream) {
    const float* x = (const float*)d_in[0]; const int* pos = (const int*)d_in[1]; const float* ng = (const float*)d_in[2]; const float* w_in = (const float*)d_in[3];
    const float* lq1 = (const float*)d_in[4]; const float* lk1 = (const float*)d_in[5]; const float* lq2 = (const float*)d_in[6]; const float* lk2 = (const float*)d_in[7];
    const float* subln = (const float*)d_in[8]; const float* cw = (const float*)d_in[9]; const float* cb = (const float*)d_in[10];
    const float* wa = (const float*)d_in[11]; const float* ba = (const float*)d_in[12]; const float* wx = (const float*)d_in[13]; const float* bx = (const float*)d_in[14];
    const float* lam = (const float*)d_in[15]; const float* w_out = (const float*)d_in[16]; const float* fg = (const float*)d_in[17];
    float* out = (float*)d_out;
    char* ws = (char*)d_ws;
    float* proj = (float*)ws;
    float* mix = (float*)(ws + (size_t)192 * 1024 * 1024);
    float* hbuf = out;
    float* ybuf = out;
    float* abuf = out + (size_t)M * RW;
    k_rmsnorm<<<M, 256, 0, stream>>>(x, nullptr, ng, hbuf);
    k_gemm<<<dim3(INW / 64, M / 64), 256, 0, stream>>>(hbuf, w_in, proj, M, INW, DM);
    k_rope<<<M, 256, 0, stream>>>(proj, pos);
    k_attn<<<M * NH / 4, 256, 0, stream>>>(proj, lq1, lk1, lq2, lk2, subln, mix);
    k_conv<<<M, 256, 0, stream>>>(proj, cw, cb, ybuf);
    k_gates<<<M, 256, 0, stream>>>(ybuf, wa, ba, wx, bx, lam, abuf, ybuf);
    k_scan<<<BATCH * RW / 256, 256, 0, stream>>>(abuf, ybuf, proj, mix);
    float* y2 = proj;
    k_gemm<<<dim3(DM / 64, M / 64), 256, 0, stream>>>(mix, w_out, y2, M, DM, AW + RW);
    k_rmsnorm<<<M, 256, 0, stream>>>(x, y2, fg, out);
}
```

```cpp
#include <hip/hip_runtime.h>
#include <hip/hip_cooperative_groups.h>
namespace cg = cooperative_groups;
#include <cstdio>
#include <cstdint>
#include <cmath>

constexpr int BATCH = 4, SEQ = 2048, DM = 2048, M = BATCH * SEQ;
constexpr int AW = 1024, RW = 1024, NH = 8, HD = 128, QK = 64, NRB = 8, RB = 128, CW = 4;
constexpr int INW = 6144;
constexpr int C_Q = 0, C_K = 1024, C_V = 2048, C_GA = 3072, C_XR = 4096, C_GR = 5120;
constexpr float EPS = 1e-6f, LRU_C = 8.0f;


constexpr int NT = 512;
constexpr int LDS_BYTES = 147456;
#define LAS __attribute__((address_space(3)))

__device__ __forceinline__ float silu_f(float x) { return x / (1.0f + expf(-x)); }
__device__ __forceinline__ float sigmoid_f(float x) { return 1.0f / (1.0f + expf(-x)); }

__device__ __forceinline__ float block_sum(float v, float* red) {
    for (int o = 32; o > 0; o >>= 1) v += __shfl_xor(v, o);
    const int w = threadIdx.x >> 6, l = threadIdx.x & 63;
    __syncthreads();
    if (l == 0) red[w] = v;
    __syncthreads();
    float t = 0.f;
#pragma unroll
    for (int i = 0; i < 8; ++i) t += red[i];
    return t;
}

__device__ void nv_rmsnorm(float* lds, const float* a, const float* b, const float* g, float* out) {
    float* red = lds;
    for (int row = blockIdx.x; row < M; row += gridDim.x) {
        float v[4]; float s = 0.f;
#pragma unroll
        for (int i = 0; i < 4; ++i) { const int c = threadIdx.x + NT * i; float x = a[(size_t)row * DM + c]; if (b) x += b[(size_t)row * DM + c]; v[i] = x; s += x * x; }
        const float tot = block_sum(s, red);
        const float rs = 1.0f / sqrtf(tot / DM + EPS);
#pragma unroll
        for (int i = 0; i < 4; ++i) { const int c = threadIdx.x + NT * i; out[(size_t)row * DM + c] = v[i] * rs * g[c]; }
    }
}
__device__ void nv_gemm(float* lds, const float* A, const float* B, float* C, int Mm, int Nn, int Kk) {
    float (*As)[132] = (float (*)[132])lds;
    float (*Bs)[68] = (float (*)[68])(lds + 16 * 132);
    const int tx = threadIdx.x & 15, ty = threadIdx.x >> 4;
    const int ntn = Nn / 64, ntiles = (Mm / 128) * ntn;
    for (int t = blockIdx.x; t < ntiles; t += gridDim.x) {
        const int m0 = (t / ntn) * 128, n0 = (t % ntn) * 64;
        float acc[4][4] = {};
        for (int k0 = 0; k0 < Kk; k0 += 16) {
            {
                const int r = threadIdx.x >> 2, kk = (threadIdx.x & 3) * 4;
                const float4 a = *(const float4*)(A + (size_t)(m0 + r) * Kk + k0 + kk);
                As[kk + 0][r] = a.x; As[kk + 1][r] = a.y; As[kk + 2][r] = a.z; As[kk + 3][r] = a.w;
                if (threadIdx.x < 256) { const int kr = threadIdx.x >> 4, nn = (threadIdx.x & 15) * 4;
                    *(float4*)&Bs[kr][nn] = *(const float4*)(B + (size_t)(k0 + kr) * Nn + n0 + nn); }
            }
            __syncthreads();
#pragma unroll
            for (int k = 0; k < 16; ++k) {
                const float4 a = *(const float4*)&As[k][ty * 4];
                const float4 b = *(const float4*)&Bs[k][tx * 4];
                const float av[4] = {a.x, a.y, a.z, a.w}, bv[4] = {b.x, b.y, b.z, b.w};
#pragma unroll
                for (int i = 0; i < 4; ++i)
#pragma unroll
                    for (int j = 0; j < 4; ++j) acc[i][j] = fmaf(av[i], bv[j], acc[i][j]);
            }
            __syncthreads();
        }
#pragma unroll
        for (int i = 0; i < 4; ++i) *(float4*)(C + (size_t)(m0 + ty * 4 + i) * Nn + n0 + tx * 4) = make_float4(acc[i][0], acc[i][1], acc[i][2], acc[i][3]);
    }
}
__device__ void nv_rope(float* proj, const int* pos) {
    for (int row = blockIdx.x; row < M; row += gridDim.x) {
        const float p = (float)pos[row];
        for (int i = threadIdx.x; i < 1024; i += NT) {
            const int j = i & 31, grp = i >> 5;
            const float inv_freq = powf(10000.0f, -(float)(2 * j) / 64.0f);
            const float ang = p * inv_freq;
            const float c = cosf(ang), s = sinf(ang);
            float* base = proj + (size_t)row * INW + grp * 64;
            const float t1 = base[j], t2 = base[j + 32];
            base[j] = t1 * c - t2 * s; base[j + 32] = t2 * c + t1 * s;
        }
    }
}
__device__ void nv_attn(float* lds, const float* proj, const float* lq1, const float* lk1, const float* lq2, const float* lk2, const float* subln, float* mix) {
    const int wid = threadIdx.x >> 6, lane = threadIdx.x & 63;
    float* ps0 = lds + wid * 256; float* ps1 = ps0 + 64; float* qs = ps0 + 128;
    float a1 = lq1[lane] * lk1[lane], a2 = lq2[lane] * lk2[lane];
    for (int o = 32; o > 0; o >>= 1) { a1 += __shfl_xor(a1, o); a2 += __shfl_xor(a2, o); }
    const float lam_init = 0.8f - 0.6f * expf(-0.3f * 0.0f);
    const float lam = expf(a1) - expf(a2) + lam_init;
    const float scale = 0.125f;
    for (int task = blockIdx.x * 8 + wid; task < M * NH; task += gridDim.x * 8) {
        const int row = task / NH, h = task % NH;
        const int b = row / SEQ, s = row % SEQ;
        const float* qrow = proj + (size_t)row * INW + C_Q + h * 128;
        __builtin_amdgcn_wave_barrier();
        qs[lane] = qrow[lane]; qs[64 + lane] = qrow[64 + lane];
        __builtin_amdgcn_wave_barrier();
        const float* q0 = qs; const float* q1 = qs + 64;
        float m0 = -INFINITY, m1 = -INFINITY;
        for (int k0 = 0; k0 <= s; k0 += 64) {
            const int k = k0 + lane;
            if (k <= s) {
                const float* krow = proj + (size_t)(b * SEQ + k) * INW + C_K + h * 128;
                float s0 = 0.f, s1 = 0.f;
                for (int d = 0; d < 64; d += 4) { const float4 ka = *(const float4*)(krow + d), kb = *(const float4*)(krow + 64 + d);
                    s0 = fmaf(q0[d], ka.x, s0); s0 = fmaf(q0[d + 1], ka.y, s0); s0 = fmaf(q0[d + 2], ka.z, s0); s0 = fmaf(q0[d + 3], ka.w, s0);
                    s1 = fmaf(q1[d], kb.x, s1); s1 = fmaf(q1[d + 1], kb.y, s1); s1 = fmaf(q1[d + 2], kb.z, s1); s1 = fmaf(q1[d + 3], kb.w, s1); }
                m0 = fmaxf(m0, s0 * scale); m1 = fmaxf(m1, s1 * scale);
            }
        }
        for (int o = 32; o > 0; o >>= 1) { m0 = fmaxf(m0, __shfl_xor(m0, o)); m1 = fmaxf(m1, __shfl_xor(m1, o)); }
        float l0 = 0.f, l1 = 0.f, o0a = 0.f, o0b = 0.f, o1a = 0.f, o1b = 0.f;
        for (int k0 = 0; k0 <= s; k0 += 64) {
            const int k = k0 + lane;
            float p0 = 0.f, p1 = 0.f;
            if (k <= s) {
                const float* krow = proj + (size_t)(b * SEQ + k) * INW + C_K + h * 128;
                float s0 = 0.f, s1 = 0.f;
                for (int d = 0; d < 64; d += 4) { const float4 ka = *(const float4*)(krow + d), kb = *(const float4*)(krow + 64 + d);
                    s0 = fmaf(q0[d], ka.x, s0); s0 = fmaf(q0[d + 1], ka.y, s0); s0 = fmaf(q0[d + 2], ka.z, s0); s0 = fmaf(q0[d + 3], ka.w, s0);
                    s1 = fmaf(q1[d], kb.x, s1); s1 = fmaf(q1[d + 1], kb.y, s1); s1 = fmaf(q1[d + 2], kb.z, s1); s1 = fmaf(q1[d + 3], kb.w, s1); }
                p0 = expf(s0 * scale - m0); p1 = expf(s1 * scale - m1);
            }
            l0 += p0; l1 += p1;
            __builtin_amdgcn_wave_barrier();
            ps0[lane] = p0; ps1[lane] = p1;
            __builtin_amdgcn_wave_barrier();
            const int kmax = (s - k0 + 1) < 64 ? (s - k0 + 1) : 64;
            for (int j = 0; j < kmax; ++j) {
                const float* vrow = proj + (size_t)(b * SEQ + k0 + j) * INW + C_V + h * 128;
                const float va = vrow[lane], vb = vrow[64 + lane];
                const float w0 = ps0[j], w1 = ps1[j];
                o0a = fmaf(w0, va, o0a); o0b = fmaf(w0, vb, o0b); o1a = fmaf(w1, va, o1a); o1b = fmaf(w1, vb, o1b);
            }
        }
        for (int o = 32; o > 0; o >>= 1) { l0 += __shfl_xor(l0, o); l1 += __shfl_xor(l1, o); }
        const float oa = o0a / l0 - lam * (o1a / l1), ob = o0b / l0 - lam * (o1b / l1);
        float ss = oa * oa + ob * ob;
        for (int o = 32; o > 0; o >>= 1) ss += __shfl_xor(ss, o);
        const float rs = 1.0f / sqrtf(ss / 128.0f + EPS);
        const float* grow = proj + (size_t)row * INW + C_GA + h * 128;
        float* mrow = mix + (size_t)row * (AW + RW) + h * 128;
        mrow[lane] = oa * rs * subln[lane] * (1.0f - lam_init) * silu_f(grow[lane]);
        mrow[64 + lane] = ob * rs * subln[64 + lane] * (1.0f - lam_init) * silu_f(grow[64 + lane]);
    }
}
__device__ void nv_conv(const float* proj, const float* cw, const float* cb, float* y) {
    for (int row = blockIdx.x; row < M; row += gridDim.x) {
        const int s = row % SEQ;
        for (int c = threadIdx.x; c < RW; c += NT) {
            float acc = cb[c];
            for (int j = 0; j < CW; ++j) { const int t = s - 3 + j; if (t >= 0) acc = fmaf(cw[j * RW + c], proj[(size_t)(row - 3 + j) * INW + C_XR + c], acc); }
            y[(size_t)row * RW + c] = acc;
        }
    }
}
__device__ void nv_gates(float* lds, const float* y, const float* wa, const float* ba, const float* wx, const float* bx, const float* lam, float* aout, float* uout) {
    float* ys = lds;
    for (int row = blockIdx.x; row < M; row += gridDim.x) {
        __syncthreads();
        for (int c = threadIdx.x; c < RW; c += NT) ys[c] = y[(size_t)row * RW + c];
        __syncthreads();
        for (int c = threadIdx.x; c < RW; c += NT) {
            const int n = c / RB, j = c % RB;
            float ga = 0.f, gx = 0.f;
            for (int i = 0; i < RB; ++i) { const float yi = ys[n * RB + i]; ga = fmaf(yi, wa[((size_t)n * RB + i) * RB + j], ga); gx = fmaf(yi, wx[((size_t)n * RB + i) * RB + j], gx); }
            const float r = sigmoid_f(ga + ba[c]), ig = sigmoid_f(gx + bx[c]);
            const float L = lam[c];
            const float sp = (-L > 20.f) ? -L : log1pf(expf(-L));
            const float log_a = -LRU_C * r * sp;
            const float a = expf(log_a);
            const float mult = sqrtf(-expm1f(2.0f * log_a));
            aout[(size_t)row * RW + c] = a;
            uout[(size_t)row * RW + c] = mult * (ig * ys[c]);
        }
    }
}
__device__ void nv_scan(const float* a, const float* u, const float* proj, float* mix) {
    for (int idx = blockIdx.x * NT + threadIdx.x; idx < BATCH * RW; idx += gridDim.x * NT) {
        const int b = idx / RW, c = idx % RW;
        float h = 0.f;
        for (int s = 0; s < SEQ; ++s) {
            const size_t row = (size_t)b * SEQ + s;
            h = fmaf(a[row * RW + c], h, u[row * RW + c]);
            mix[row * (AW + RW) + AW + c] = h * silu_f(proj[row * INW + C_GR + c]);
        }
    }
}

struct Args { const void* in[18]; float* out; unsigned char* ws; };

__global__ void __launch_bounds__(NT, 2) fwd_mega(Args args) {
    extern __shared__ __attribute__((aligned(16))) unsigned char lds_raw[];
    float* lds = (float*)lds_raw;
    cg::grid_group grid = cg::this_grid();
    const float* x = (const float*)args.in[0]; const int* pos = (const int*)args.in[1]; const float* ng = (const float*)args.in[2]; const float* w_in = (const float*)args.in[3];
    const float* lq1 = (const float*)args.in[4]; const float* lk1 = (const float*)args.in[5]; const float* lq2 = (const float*)args.in[6]; const float* lk2 = (const float*)args.in[7];
    const float* subln = (const float*)args.in[8]; const float* cw = (const float*)args.in[9]; const float* cb = (const float*)args.in[10];
    const float* wa = (const float*)args.in[11]; const float* ba = (const float*)args.in[12]; const float* wx = (const float*)args.in[13]; const float* bx = (const float*)args.in[14];
    const float* lam = (const float*)args.in[15]; const float* w_out = (const float*)args.in[16]; const float* fg = (const float*)args.in[17];
    float* out = args.out; unsigned char* ws = args.ws;
    float* proj = (float*)ws;
    float* mix = (float*)(ws + (size_t)192 * 1024 * 1024);
    float* hbuf = out; float* ybuf = out; float* abuf = out + (size_t)M * RW;
    nv_rmsnorm(lds, x, nullptr, ng, hbuf);
    grid.sync();
    nv_gemm(lds, hbuf, w_in, proj, M, INW, DM);
    grid.sync();
    nv_rope(proj, pos);
    grid.sync();
    nv_attn(lds, proj, lq1, lk1, lq2, lk2, subln, mix);
    nv_conv(proj, cw, cb, ybuf);
    grid.sync();
    nv_gates(lds, ybuf, wa, ba, wx, bx, lam, abuf, ybuf);
    grid.sync();
    nv_scan(abuf, ybuf, proj, mix);
    grid.sync();
    float* y2 = proj;
    nv_gemm(lds, mix, w_out, y2, M, DM, AW + RW);
    grid.sync();
    nv_rmsnorm(lds, x, y2, fg, out);
}

extern "C" void kernel_launch(void* const* d_in, const int* in_sizes, int n_in, void* d_out, int out_size, void* d_ws, size_t ws_size, hipStream_t stream) {
    static int grid_blocks = 0;
    if (!grid_blocks) {
        int dev = 0, cus = 0, per_cu = 0;
        hipGetDevice(&dev);
        hipDeviceGetAttribute(&cus, hipDeviceAttributeMultiprocessorCount, dev);
        hipFuncSetAttribute((const void*)fwd_mega, hipFuncAttributeMaxDynamicSharedMemorySize, LDS_BYTES);
        hipOccupancyMaxActiveBlocksPerMultiprocessor(&per_cu, (const void*)fwd_mega, NT, LDS_BYTES);
        if (per_cu < 1) { fprintf(stderr, "occupancy query says %d blocks per CU\n", per_cu); per_cu = 1; }
        grid_blocks = cus * 1;
        fprintf(stderr, "fwd_mega: cus %d per_cu %d grid %d\n", cus, per_cu, grid_blocks);
    }
    Args a{};
    for (int i = 0; i < 18; ++i) a.in[i] = d_in[i];
    a.out = (float*)d_out; a.ws = (unsigned char*)d_ws;
    void* kargs[] = {&a};
    hipError_t e = hipLaunchCooperativeKernel((const void*)fwd_mega, dim3(grid_blocks), dim3(NT), kargs, LDS_BYTES, stream);
    if (e != hipSuccess) fprintf(stderr, "cooperative launch failed: %s (grid %d)\n", hipGetErrorString(e), grid_blocks);
}
```

```cpp
#include <hip/hip_runtime.h>
#include <hip/hip_cooperative_groups.h>
#include <cstdio>
#include <cstdint>
#include <cmath>
namespace cg = cooperative_groups;

constexpr int BATCH = 4, SEQ = 2048, DM = 2048, M = BATCH * SEQ;
constexpr int AW = 1024, RW = 1024, NH = 8, HD = 128, QK = 64, NRB = 8, RB = 128, CW = 4;
constexpr int INW = 6144;
constexpr int C_Q = 0, C_K = 1024, C_V = 2048, C_GA = 3072, C_XR = 4096, C_GR = 5120;
constexpr float EPS = 1e-6f, LRU_C = 8.0f;
constexpr int NT = 512;
constexpr int NWAVES = 8;
constexpr int LDS_BYTES = 147456;
#define LAS __attribute__((address_space(3)))
#define GAS __attribute__((address_space(1)))
typedef unsigned short bf16;
typedef unsigned v4u __attribute__((ext_vector_type(4)));

constexpr size_t MiB = 1u << 20;
constexpr size_t WS_CTL = 0, WS_WIN = 1 * MiB, WS_WOUT = 25 * MiB, WS_WG = 33 * MiB, WS_ROPE = 34 * MiB, WS_XN = 36 * MiB;
constexpr size_t WS_Q = 68 * MiB, WS_K = 84 * MiB, WS_V = 100 * MiB, WS_GA = 116 * MiB, WS_XR = 132 * MiB, WS_GR = 148 * MiB, WS_MIX = 164 * MiB;
constexpr size_t SEG_ELEMS = (size_t)M * 1024;
static_assert(WS_K - WS_Q == SEG_ELEMS * 2, "segment stride");
constexpr size_t WS_PART = 196 * MiB;

namespace pg8 {
#define PG8_LAS __attribute__((address_space(3)))
typedef unsigned short bf16_t;
typedef short bf16x8 __attribute__((ext_vector_type(8)));
typedef float f32x4 __attribute__((ext_vector_type(4)));
typedef unsigned u32x4 __attribute__((ext_vector_type(4)));
constexpr int BM = 256, BK = 64, HALF = 128, HTB = HALF * BK * 2  , STAGE_BYTES = 8 * HTB, NXCD = 8, WGM = 8;

__host__ __device__ __forceinline__ int lds_byte(int r, int c) { const int st = (r >> 4) * 2 + (c >> 5), rr = r & 15, cc = c & 31, ob = rr * 64 + cc * 2; return st * 1024 + (ob ^ (((ob >> 9) & 1) << 5)); }
__host__ __device__ __forceinline__ void stage_rc(int b, int& R, int& C) { const int st = b / 1024, sb = b % 1024, swz = sb ^ (((sb >> 9) & 1) << 5); R = (st >> 1) * 16 + swz / 64; C = (st & 1) * 32 + (swz % 64) / 2; }
__host__ __device__ __forceinline__ int perm32(int rho) { const int n = rho >> 4, i = rho & 15; return 8 * (i >> 2) + 4 * n + (i & 3); }

struct Unit { int pm, pn; };
struct Gemm { const bf16_t* A; const bf16_t* Bt; int M, N, K; };

struct StaticOrder {
    int nM, nN, nwg, G, c;
    __host__ __device__ void init(int M, int N, int G_, int c_) { nM = M / BM; nN = N / BM; nwg = nM * nN; G = G_; c = c_; }
    __host__ __device__ bool next(int i, Unit& u) const {
        const long L = (long)i * G + c; if (L >= nwg) return false;
        int wgid = (int)L; { const int q = nwg / NXCD, r = nwg % NXCD, xcd = wgid % NXCD, off = wgid / NXCD; wgid = (xcd < r ? xcd * (q + 1) : r * (q + 1) + (xcd - r) * q) + off; }
        const int nig = WGM * nN, gid = wgid / nig, fm = gid * WGM, gsz = (nM - fm) < WGM ? (nM - fm) : WGM;
        u.pm = fm + ((wgid % nig) % gsz); u.pn = (wgid % nig) / gsz; return true;
    }
    __device__ __forceinline__ void a_ready(const Unit&) const {}
    __device__ __forceinline__ void done(const Unit&) const {}
};
__device__ __forceinline__ unsigned cvt_pk_bf16(float lo, float hi) { unsigned r; asm volatile("v_cvt_pk_bf16_f32 %0, %1, %2" : "=v"(r) : "v"(lo), "v"(hi)); return r; }
typedef float f32x2 __attribute__((ext_vector_type(2)));

__device__ __forceinline__ float silu_fast(float x) { return x * __builtin_amdgcn_rcpf(1.0f + __builtin_amdgcn_exp2f(-1.4426950408889634f * x)); }
struct EpiProj {
    static constexpr bool PERM = true, AFTER_DRAIN = false;
    bf16_t* base; const float* cs;
    __device__ __forceinline__ void operator()(const f32x4 (&acc)[2][2][4][2], const Unit& u, int wr, int wc, int fr, int fq) const {
        const int seg = u.pn >> 2, colt = (u.pn & 3) * BM;
        bf16_t* O = base + (size_t)seg * ((size_t)8192 * 1024);
        const int row0 = u.pm * BM + wr * 64 + fr, col0 = colt + wc * 32 + 8 * fq;
        const int j0 = 16 * (wc & 1) + 4 * fq;
#pragma unroll
        for (int ai = 0; ai < 2; ++ai)
#pragma unroll
            for (int m = 0; m < 4; ++m) {
                const int row = row0 + ai * HALF + m * 16;
                bf16_t* rowp = O + (size_t)row * 1024 + col0;
                f32x4 ca = {1.f, 0.f, 1.f, 0.f}, cb = {1.f, 0.f, 1.f, 0.f};
                if (seg < 2) { ca = *(const f32x4*)(cs + (size_t)row * 64 + 2 * j0); cb = *(const f32x4*)(cs + (size_t)row * 64 + 2 * j0 + 4); }
#pragma unroll
                for (int bj = 0; bj < 2; ++bj) {
                    f32x4 v0 = acc[ai][bj][m][0], v1 = acc[ai][bj][m][1];
                    if (seg < 2) {
                        const float sc = (seg == 0) ? 0.125f : 1.0f;
                        f32x4 r0, r1;
                        r0[0] = (v0[0] * ca[0] - v0[1] * ca[1]) * sc; r0[1] = (v0[1] * ca[0] + v0[0] * ca[1]) * sc;
                        r0[2] = (v0[2] * ca[2] - v0[3] * ca[3]) * sc; r0[3] = (v0[3] * ca[2] + v0[2] * ca[3]) * sc;
                        r1[0] = (v1[0] * cb[0] - v1[1] * cb[1]) * sc; r1[1] = (v1[1] * cb[0] + v1[0] * cb[1]) * sc;
                        r1[2] = (v1[2] * cb[2] - v1[3] * cb[3]) * sc; r1[3] = (v1[3] * cb[2] + v1[2] * cb[3]) * sc;
                        v0 = r0; v1 = r1;
                    } else if (seg == 3 || seg == 5) {
#pragma unroll
                        for (int e = 0; e < 4; ++e) { v0[e] = silu_fast(v0[e]); v1[e] = silu_fast(v1[e]); }
                    }
                    u32x4 w; w.x = cvt_pk_bf16(v0[0], v0[1]); w.y = cvt_pk_bf16(v0[2], v0[3]); w.z = cvt_pk_bf16(v1[0], v1[1]); w.w = cvt_pk_bf16(v1[2], v1[3]);
                    *(u32x4*)(rowp + bj * HALF) = w;
                }
            }
    }
};

struct EpiOut {
    static constexpr bool PERM = false, AFTER_DRAIN = false;
    const float* xres; float* out; float* part;
    __device__ __forceinline__ void operator()(const f32x4 (&acc)[2][2][4][2], const Unit& u, int wr, int wc, int fr, int fq) const {
        const int row0 = u.pm * BM + wr * 64 + fr, col0 = u.pn * BM + wc * 32 + 4 * fq;
#pragma unroll
        for (int ai = 0; ai < 2; ++ai)
#pragma unroll
            for (int m = 0; m < 4; ++m) {
                const int row = row0 + ai * HALF + m * 16; const size_t off = (size_t)row * 2048 + col0; float s = 0.f;
#pragma unroll
                for (int bj = 0; bj < 2; ++bj)
#pragma unroll
                    for (int n = 0; n < 2; ++n) { const f32x4 y = acc[ai][bj][m][n] + *(const f32x4*)(xres + off + bj * HALF + n * 16);
                        s += (y[0] * y[0] + y[1] * y[1]) + (y[2] * y[2] + y[3] * y[3]); *(f32x4*)(out + off + bj * HALF + n * 16) = y; }
                s += __shfl_xor(s, 16); s += __shfl_xor(s, 32);
                if (fq == 0) part[(size_t)row * 32 + 4 * u.pn + wc] = s;
            }
    }
};
template <class Epi, class Sched, bool ALIGN_EPI = false, bool SP2 = false>
__device__ __forceinline__ void gemm_phase(PG8_LAS unsigned char* lds, const Gemm g, const Sched& S, const Epi& E) {
    const int tid = threadIdx.x, wid = __builtin_amdgcn_readfirstlane(tid >> 6), lane = tid & 63, wr = wid >> 2, wc = wid & 3, fr = lane & 15, fq = lane >> 4;
    const int K = g.K, nt = K / BK;
    unsigned voffA[2], voffB[2];
#pragma unroll
    for (int i = 0; i < 2; ++i) { int R, C; stage_rc(tid * 16 + i * 8192, R, C); const int Rb = Epi::PERM ? ((R & ~31) + perm32(R & 31)) : R;
        voffA[i] = (unsigned)(R * K + C) * 2u; voffB[i] = (unsigned)(Rb * K + C) * 2u; }
    const size_t kstep = (size_t)(BK * 2);
    const size_t hstep = (size_t)HALF * K * 2;
    const size_t tstep = 2 * hstep;
    const unsigned ldsw = (unsigned)wid * 1024u;
    const int aoff = lds_byte(wr * 64 + fr, fq * 8), boff = lds_byte(wc * 32 + fr, fq * 8);
#define PG8_SA(b, h) (((b) * 2 + (h)) * HTB)
#define PG8_SB(b, h) ((4 + (b) * 2 + (h)) * HTB)
#define PG8_STAGE(bufoff, gbase, voff) do { _Pragma("unroll") for (int _i = 0; _i < 2; ++_i) \
        __builtin_amdgcn_global_load_lds((const unsigned*)((const char*)(gbase) + (voff)[_i]), (PG8_LAS unsigned*)(lds + (bufoff) + ldsw + _i * 8192), 16, 0, 0); } while (0)
#define PG8_LDA(dst, b, h) do { _Pragma("unroll") for (int m = 0; m < 4; ++m) _Pragma("unroll") for (int k = 0; k < 2; ++k) dst[m][k] = *(const PG8_LAS bf16x8*)(lds + PG8_SA(b, h) + aoff + m * 2048 + k * 1024); } while (0)
#define PG8_LDB(dst, b, h) do { _Pragma("unroll") for (int n = 0; n < 2; ++n) _Pragma("unroll") for (int k = 0; k < 2; ++k) dst[n][k] = *(const PG8_LAS bf16x8*)(lds + PG8_SB(b, h) + boff + n * 2048 + k * 1024); } while (0)
#define PG8_MMA(ai, bj, At, Bt) do { __builtin_amdgcn_s_setprio(1); _Pragma("unroll") for (int m = 0; m < 4; ++m) _Pragma("unroll") for (int n = 0; n < 2; ++n) _Pragma("unroll") for (int k = 0; k < 2; ++k) \
        acc[ai][bj][m][n] = __builtin_amdgcn_mfma_f32_16x16x32_bf16(Bt[n][k], At[m][k], acc[ai][bj][m][n], 0, 0, 0); __builtin_amdgcn_s_setprio(0); } while (0)
#define PG8_WAIT_V(n) asm volatile("s_waitcnt vmcnt(" #n ")" ::: "memory")
#define PG8_WAIT_L(n) asm volatile("s_waitcnt lgkmcnt(" #n ")" ::: "memory")
#define PG8_BAR __builtin_amdgcn_s_barrier()
#define PG8_SCHED __builtin_amdgcn_sched_barrier(0)
    Unit cur, nxt; int ui = 0;
    if (!S.next(0, cur)) return;
    f32x4 acc[2][2][4][2];
#pragma unroll
    for (int a = 0; a < 2; ++a)
#pragma unroll
        for (int b = 0; b < 2; ++b)
#pragma unroll
            for (int m = 0; m < 4; ++m)
#pragma unroll
                for (int n = 0; n < 2; ++n) acc[a][b][m][n] = (f32x4){0.f, 0.f, 0.f, 0.f};
    bf16x8 At[4][2], B0[2][2], B1[2][2];
    const char* cA = (const char*)g.A + (size_t)cur.pm * tstep; const char* cB = (const char*)g.Bt + (size_t)cur.pn * tstep;
    S.a_ready(cur);
    if constexpr (SP2) {
        PG8_STAGE(PG8_SB(0, 0), cB, voffB); PG8_STAGE(PG8_SB(0, 1), cB + hstep, voffB); PG8_STAGE(PG8_SA(0, 0), cA, voffA); PG8_STAGE(PG8_SA(0, 1), cA + hstep, voffA);
        if (wr == 1) PG8_BAR;
        PG8_WAIT_V(2); PG8_BAR;
        PG8_STAGE(PG8_SB(1, 0), cB + kstep, voffB); PG8_STAGE(PG8_SA(1, 0), cA + kstep, voffA); PG8_STAGE(PG8_SB(1, 1), cB + hstep + kstep, voffB);
        PG8_WAIT_V(6); PG8_BAR;
    } else {
        PG8_STAGE(PG8_SB(0, 0), cB, voffB); PG8_STAGE(PG8_SA(0, 0), cA, voffA); PG8_STAGE(PG8_SB(0, 1), cB + hstep, voffB); PG8_STAGE(PG8_SA(0, 1), cA + hstep, voffA);
        if (wr == 1) PG8_BAR;
        PG8_WAIT_V(4); PG8_BAR;
        PG8_STAGE(PG8_SB(1, 0), cB + kstep, voffB); PG8_STAGE(PG8_SA(1, 0), cA + kstep, voffA); PG8_STAGE(PG8_SB(1, 1), cB + hstep + kstep, voffB);
        PG8_WAIT_V(6); PG8_BAR;
    }
    for (;;) {
        const bool has_next = S.next(ui + 1, nxt);
        const char* nA = has_next ? (const char*)g.A + (size_t)nxt.pm * tstep : cA; const char* nB = has_next ? (const char*)g.Bt + (size_t)nxt.pn * tstep : cB;
        for (int t = 0; t < nt; t += 2) {
            const bool last = (t == nt - 2);
            const char* a1 = cA + (size_t)(t + 1) * kstep;
            const char* a2 = last ? nA : cA + (size_t)(t + 2) * kstep; const char* b2 = last ? nB : cB + (size_t)(t + 2) * kstep;
            const char* a3 = a2 + kstep; const char* b3 = b2 + kstep;
            if (last && has_next) S.a_ready(nxt);
            if constexpr (SP2) {
            PG8_LDB(B0, 0, 0); PG8_LDB(B1, 0, 1); PG8_SCHED; PG8_LDA(At, 0, 0); PG8_STAGE(PG8_SA(1, 1), a1 + hstep, voffA);
            PG8_WAIT_V(8); PG8_WAIT_L(0); PG8_BAR; PG8_MMA(0, 0, At, B0); PG8_MMA(0, 1, At, B1); PG8_BAR; PG8_SCHED;
            PG8_LDA(At, 0, 1); PG8_STAGE(PG8_SB(0, 0), b2, voffB); PG8_STAGE(PG8_SB(0, 1), b2 + hstep, voffB); PG8_STAGE(PG8_SA(0, 0), a2, voffA);
            PG8_WAIT_V(8); PG8_WAIT_L(0); PG8_BAR; PG8_MMA(1, 0, At, B0); PG8_MMA(1, 1, At, B1); PG8_BAR; PG8_SCHED;
            PG8_LDB(B0, 1, 0); PG8_LDB(B1, 1, 1); PG8_SCHED; PG8_LDA(At, 1, 0); PG8_STAGE(PG8_SA(0, 1), a2 + hstep, voffA);
            PG8_WAIT_V(8); PG8_WAIT_L(0); PG8_BAR; PG8_MMA(0, 0, At, B0); PG8_MMA(0, 1, At, B1); PG8_BAR; PG8_SCHED;
            PG8_LDA(At, 1, 1); PG8_STAGE(PG8_SB(1, 0), b3, voffB); PG8_STAGE(PG8_SB(1, 1), b3 + hstep, voffB); PG8_STAGE(PG8_SA(1, 0), a3, voffA);
            PG8_WAIT_V(8); PG8_WAIT_L(0); PG8_BAR; PG8_MMA(1, 0, At, B0); PG8_MMA(1, 1, At, B1); PG8_BAR; PG8_SCHED;
            } else {
            PG8_LDB(B0, 0, 0); PG8_SCHED; PG8_LDA(At, 0, 0); PG8_STAGE(PG8_SA(1, 1), a1 + hstep, voffA);
            PG8_WAIT_L(8); PG8_BAR; PG8_WAIT_L(0); PG8_MMA(0, 0, At, B0); PG8_BAR; PG8_SCHED;
            PG8_LDB(B1, 0, 1); PG8_STAGE(PG8_SB(0, 0), b2, voffB);
            PG8_BAR; PG8_WAIT_L(0); PG8_MMA(0, 1, At, B1); PG8_BAR;
            PG8_LDA(At, 0, 1); PG8_STAGE(PG8_SA(0, 0), a2, voffA);
            PG8_BAR; PG8_WAIT_L(0); PG8_MMA(1, 0, At, B0); PG8_BAR; PG8_SCHED;
            PG8_STAGE(PG8_SB(0, 1), b2 + hstep, voffB);
            PG8_WAIT_V(6); PG8_BAR; PG8_MMA(1, 1, At, B1); PG8_BAR;
            PG8_LDB(B0, 1, 0); PG8_SCHED; PG8_LDA(At, 1, 0); PG8_STAGE(PG8_SA(0, 1), a2 + hstep, voffA);
            PG8_WAIT_L(8); PG8_BAR; PG8_WAIT_L(0); PG8_MMA(0, 0, At, B0); PG8_BAR; PG8_SCHED;
            PG8_LDB(B1, 1, 1); PG8_STAGE(PG8_SB(1, 0), b3, voffB);
            PG8_BAR; PG8_WAIT_L(0); PG8_MMA(0, 1, At, B1); PG8_BAR;
            PG8_LDA(At, 1, 1); PG8_STAGE(PG8_SA(1, 0), a3, voffA);
            PG8_BAR; PG8_WAIT_L(0); PG8_MMA(1, 0, At, B0); PG8_BAR; PG8_SCHED;
            PG8_STAGE(PG8_SB(1, 1), b3 + hstep, voffB);
            PG8_WAIT_V(6); PG8_BAR; PG8_MMA(1, 1, At, B1); PG8_BAR;
            }
        }
        if constexpr (ALIGN_EPI) { if (wr == 0) PG8_BAR; }
        if constexpr (!Epi::AFTER_DRAIN) { E(acc, cur, wr, wc, fr, fq); S.done(cur); }
        if (!has_next) break;
#pragma unroll
        for (int a = 0; a < 2; ++a)
#pragma unroll
            for (int b = 0; b < 2; ++b)
#pragma unroll
                for (int m = 0; m < 4; ++m)
#pragma unroll
                    for (int n = 0; n < 2; ++n) acc[a][b][m][n] = (f32x4){0.f, 0.f, 0.f, 0.f};
        cur = nxt; cA = nA; cB = nB; ++ui;
        if constexpr (ALIGN_EPI) { if (wr == 1) PG8_BAR; }
    }
    PG8_WAIT_V(0);
    if constexpr (!ALIGN_EPI) { if (wr == 0) PG8_BAR; }
    PG8_BAR;
    if constexpr (Epi::AFTER_DRAIN) { E.fused(acc, cur, wr, wc, fr, fq, lds, wid, lane); S.done(cur); }
#undef PG8_SA
#undef PG8_SB
#undef PG8_STAGE
#undef PG8_LDA
#undef PG8_LDB
#undef PG8_MMA
#undef PG8_WAIT_V
#undef PG8_WAIT_L
#undef PG8_BAR
#undef PG8_SCHED
}
}

namespace att {
typedef short bf16x8 __attribute__((ext_vector_type(8)));
typedef short s16x4 __attribute__((ext_vector_type(4)));
typedef float f32x16 __attribute__((ext_vector_type(16)));
typedef float f32x4 __attribute__((ext_vector_type(4)));
typedef unsigned u32x4 __attribute__((ext_vector_type(4)));
typedef unsigned short bf16;
constexpr int NW = 8, QBLK = 32, KVBLK = 64, QB = 128, D = 128, LDQ = 1024, LDO = 2048;
constexpr int SHM_V = KVBLK * D * 2, SHM_K = KVBLK * D * 2;
constexpr int LDS_WS = 2 * SHM_V + 2 * SHM_K, LDS_XCH = LDS_WS + NW * 64 * 4, LDS_ATT_BYTES = LDS_XCH + 4 * 16384;
constexpr float THR = 8.f, LOG2E = 1.4426950408889634f;
constexpr unsigned WBIG = 1u << 24;
#define KSWZ(row, colB) ((row) * 256 + ((colB) ^ (((row) & 7) << 4)))
#define SBAR() __builtin_amdgcn_sched_barrier(0)
__device__ __forceinline__ int v_st(int k, int c) { const int kk = (k & ~0xC) | ((k & 4) << 1) | ((k & 8) >> 1); return ((kk >> 3) * 4 + (c >> 5)) * 512 + ((kk & 7) * 32 + (c & 31)) * 2; }
__device__ __forceinline__ int v_rd_base(int lane) { return ((lane & 3) << 3) | (((lane >> 2) & 3) << 6) | (((lane >> 4) & 1) << 5) | (((lane >> 5) & 1) << 8); }
constexpr int v_rd_off(int d0, int ks, int half) { return d0 * 512 + ks * 4096 + half * 2048; }
__device__ __forceinline__ int crow(int r, int hi) { return (r & 3) + 8 * (r >> 2) + 4 * hi; }
__device__ __forceinline__ unsigned cvtpk(float lo, float hi) { unsigned r; asm volatile("v_cvt_pk_bf16_f32 %0, %1, %2" : "=v"(r) : "v"(lo), "v"(hi)); return r; }
__device__ __forceinline__ bf16x8 load8(const bf16* p) { return *reinterpret_cast<const bf16x8*>(p); }
__device__ __forceinline__ void mask_tile(f32x16& p0, f32x16& p1, int dq, unsigned W) {
    const float NEG = -__builtin_inff();
#pragma unroll
    for (int r = 0; r < 16; ++r) {
        const int c = (r & 3) + 8 * (r >> 2);
        if ((unsigned)(dq - c) >= W) p0[r] = NEG;
        if ((unsigned)(dq - c - 32) >= W) p1[r] = NEG;
    }
}
__device__ __forceinline__ void partialSM(f32x16& p0, f32x16& p1, float& m_reg, float& mn, float& alpha) {
    float pmax = p0[0]; for (int r = 1; r < 16; ++r) pmax = fmaxf(pmax, p0[r]); for (int r = 0; r < 16; ++r) pmax = fmaxf(pmax, p1[r]);
    { auto rr = __builtin_amdgcn_permlane32_swap(__float_as_uint(pmax), __float_as_uint(pmax), false, false);
      pmax = fmaxf(__uint_as_float(rr[0]), __uint_as_float(rr[1])); }
    if (__builtin_expect(__all((pmax - m_reg) <= THR), 1)) { mn = m_reg; alpha = 1.f; }
    else { mn = fmaxf(m_reg, pmax); alpha = __builtin_amdgcn_exp2f((m_reg - mn) * LOG2E); m_reg = mn; }
    const float mnL = -mn * LOG2E;
    for (int r = 0; r < 16; ++r) p0[r] = fmaf(p0[r], LOG2E, mnL); for (int r = 0; r < 16; ++r) p1[r] = fmaf(p1[r], LOG2E, mnL);
    for (int r = 0; r < 16; ++r) p0[r] = __builtin_amdgcn_exp2f(p0[r]);
}
__device__ __forceinline__ void finishSM(f32x16& p0, f32x16& p1, float alpha, float& l_reg, bf16x8& pa0, bf16x8& pa1, bf16x8& pa2, bf16x8& pa3) {
    for (int r = 0; r < 16; ++r) p1[r] = __builtin_amdgcn_exp2f(p1[r]);
    float ps = 0; for (int r = 0; r < 16; ++r) ps += p0[r]; for (int r = 0; r < 16; ++r) ps += p1[r];
    { auto rr = __builtin_amdgcn_permlane32_swap(__float_as_uint(ps), __float_as_uint(ps), false, false);
      ps = __uint_as_float(rr[0]) + __uint_as_float(rr[1]); }
    l_reg = l_reg * alpha + ps;
#define PK4(P, B_, OUT) do { unsigned a0 = cvtpk(P[B_+0], P[B_+1]), a1 = cvtpk(P[B_+2], P[B_+3]);                          \
        unsigned b0 = cvtpk(P[B_+4], P[B_+5]), b1 = cvtpk(P[B_+6], P[B_+7]);                                             \
        auto r0 = __builtin_amdgcn_permlane32_swap(a0, b0, false, false); auto r1 = __builtin_amdgcn_permlane32_swap(a1, b1, false, false); \
        u32x4 w = {r0[0], r1[0], r0[1], r1[1]}; OUT = *reinterpret_cast<bf16x8*>(&w); } while (0)
    PK4(p0, 0, pa0); PK4(p0, 8, pa1); PK4(p1, 0, pa2); PK4(p1, 8, pa3);
#undef PK4
}
template <int KB>
__device__ __forceinline__ void qkt(f32x16& p0, f32x16& p1, const char* K_lds, int r32, int hi, int kmp, const bf16x8* qr) {
    p0 = f32x16{}; p1 = f32x16{};
#pragma unroll
    for (int dd = 0; dd < 4; ++dd) { const char* a = K_lds + KB * SHM_K + KSWZ(r32, (dd * 16 + hi * 8) * 2) + kmp;
        bf16x8 b0 = *reinterpret_cast<const bf16x8*>(a);
        bf16x8 b1 = *reinterpret_cast<const bf16x8*>(a + 32 * 256);
        p0 = __builtin_amdgcn_mfma_f32_32x32x16_bf16(b0, qr[dd], p0, 0, 0, 0);
        p1 = __builtin_amdgcn_mfma_f32_32x32x16_bf16(b1, qr[dd], p1, 0, 0, 0); }
}
template <int VB>
__device__ __forceinline__ void pv_tile(f32x16* o, int vb0, bf16x8 pa0, bf16x8 pa1, bf16x8 pa2, bf16x8 pa3) {
#define TRRD(dst, off) asm volatile("ds_read_b64_tr_b16 %0, %1 offset:%2" : "=&v"(dst) : "v"(vb0), "i"(off) : "memory")
#define PV_D0(d0) do { s16x4 l0, l1, l2, l3, h0, h1, h2, h3; constexpr int b_ = VB * SHM_V + v_rd_off(d0, 0, 0); \
        TRRD(l0, b_); TRRD(h0, b_ + 2048); TRRD(l1, b_ + 4096); TRRD(h1, b_ + 6144); TRRD(l2, b_ + 8192); TRRD(h2, b_ + 10240); TRRD(l3, b_ + 12288); TRRD(h3, b_ + 14336); \
        asm volatile("s_waitcnt lgkmcnt(0)" ::: "memory"); SBAR();   \
        o[d0] = __builtin_amdgcn_mfma_f32_32x32x16_bf16(pa0, (bf16x8){l0[0], l0[1], l0[2], l0[3], h0[0], h0[1], h0[2], h0[3]}, o[d0], 0, 0, 0);   \
        o[d0] = __builtin_amdgcn_mfma_f32_32x32x16_bf16(pa1, (bf16x8){l1[0], l1[1], l1[2], l1[3], h1[0], h1[1], h1[2], h1[3]}, o[d0], 0, 0, 0);   \
        o[d0] = __builtin_amdgcn_mfma_f32_32x32x16_bf16(pa2, (bf16x8){l2[0], l2[1], l2[2], l2[3], h2[0], h2[1], h2[2], h2[3]}, o[d0], 0, 0, 0);   \
        o[d0] = __builtin_amdgcn_mfma_f32_32x32x16_bf16(pa3, (bf16x8){l3[0], l3[1], l3[2], l3[3], h3[0], h3[1], h3[2], h3[3]}, o[d0], 0, 0, 0); } while (0)
    PV_D0(0); PV_D0(1); PV_D0(2); PV_D0(3);
#undef PV_D0
#undef TRRD
}
struct BlockRef { const bf16* Q; const bf16* K; const bf16* V; const bf16* GA; bf16* O; int P0; };
struct Seam { bf16x8 qr[4]; bf16x8 st_v0, st_v1, st_k0, st_k1; };
#define ROW(p, k0, rr) ((p) + (size_t)((k0) + (rr)) * LDQ + sc)
#define VMW() asm volatile("s_waitcnt vmcnt(0)" ::: "memory")
#define VMWN(n) asm volatile("s_waitcnt vmcnt(%0)" :: "i"(n) : "memory")
#define SLOAD_H(Kp, Vp, k0) do { S.st_v0 = load8(ROW(Vp, k0, sr)); S.st_v1 = load8(ROW(Vp, k0, 32 + sr));              \
                         S.st_k0 = load8(ROW(Kp, k0, sr)); S.st_k1 = load8(ROW(Kp, k0, 32 + sr)); } while (0)
#define SWRITE_HK(bf) do { *(bf16x8*)(K_lds + (bf) * SHM_K + kws) = S.st_k0; *(bf16x8*)(K_lds + (bf) * SHM_K + kws + 32 * 256) = S.st_k1; } while (0)
#define SWRITE_HV(bf) do { *(bf16x8*)(V_lds + (bf) * SHM_V + vst0) = S.st_v0; *(bf16x8*)(V_lds + (bf) * SHM_V + vst1) = S.st_v1; } while (0)
#define SWRITE_H(bf) do { SWRITE_HV(bf); SWRITE_HK(bf); } while (0)
__device__ __forceinline__ void attn_prime(const BlockRef& cur, char* lds, Seam& S) {
    const int tid = threadIdx.x, wid = __builtin_amdgcn_readfirstlane(tid >> 6), lane = tid & 63, r32 = lane & 31, hi = lane >> 5;
    const int wq = wid & 3, mp = wid >> 2;
    const int sr = tid >> 4, sc = (tid & 15) * 8, kws = KSWZ(sr, sc * 2); char* K_lds = lds + 2 * SHM_V;
#pragma unroll
    for (int dd = 0; dd < 4; ++dd) S.qr[dd] = load8(cur.Q + (size_t)(wq * QBLK + r32) * LDQ + mp * 64 + dd * 16 + hi * 8);
    SLOAD_H(cur.K, cur.V, 0); VMW(); SWRITE_HK(0);
    __syncthreads();
}
__device__ __forceinline__ void attn_block(const BlockRef& cur, const BlockRef& nxt, float lam, const float* subln, char* lds, Seam& S) {
    const int tid = threadIdx.x, wid = __builtin_amdgcn_readfirstlane(tid >> 6), lane = tid & 63, r32 = lane & 31, hi = lane >> 5;
    const int wq = wid & 3, mp = wid >> 2, kmp = mp * 128;
    const int NT = (cur.P0 + QB - 1) / KVBLK + 1;
    const int qlo = cur.P0 + wq * QBLK, qm = qlo + r32 - 4 * hi;
    char* V_lds = lds; char* K_lds = lds + 2 * SHM_V;
    float* ws = (float*)(lds + LDS_WS) + wid * 64; float* li_l = ws, * al_l = ws + 32;
    float m_reg = -1e30f, l_reg = 0; f32x16 o[4] = {};
    const int sr = tid >> 4, sc = (tid & 15) * 8, vst0 = v_st(sr, sc), vst1 = v_st(32 + sr, sc), kws = KSWZ(sr, sc * 2);
    const int vb0 = (int)(uintptr_t)V_lds + v_rd_base(lane);
    const bf16* Kh = cur.K; const bf16* Vh = cur.V;
#define RESC(a) do { if (__any((a) < 1.f)) { if (hi == 0) al_l[r32] = (a); asm volatile("s_waitcnt lgkmcnt(0)" ::: "memory");              \
                     for (int d_ = 0; d_ < 4; ++d_) for (int r = 0; r < 16; ++r) o[d_][r] *= al_l[crow(r, hi)]; } } while (0)
#define KBASE(t) ((t) * KVBLK)
#define MASKT(P0_, P1_, t) do { const int kb_ = KBASE(t); if (kb_ + KVBLK - 1 > qlo) mask_tile(P0_, P1_, qm - kb_, WBIG); } while (0)
    constexpr int NQL = 4;
#define SEAM_K0() do { VMWN(NQL); SWRITE_HK(0); SBAR(); } while (0)
    f32x16 pA0, pA1, pB0, pB1; float mnA, mnB, alA, alB; bf16x8 pa0, pa1, pa2, pa3;
    SWRITE_HV(0); SBAR();
    if (NT > 1) { SLOAD_H(Kh, Vh, KBASE(1)); }
    SBAR(); qkt<0>(pA0, pA1, K_lds, r32, hi, kmp, S.qr);
    MASKT(pA0, pA1, 0); partialSM(pA0, pA1, m_reg, mnA, alA);
    if (NT > 1) { VMW(); SWRITE_H(1); }
    __syncthreads();
#define HALF_STEP(PX0, PX1, mnX, alX, PY0, PY1, alY, t, KB, VB, SB) do {                                                      \
        SBAR(); qkt<KB>(PX0, PX1, K_lds, r32, hi, kmp, S.qr);                                                                 \
        finishSM(PY0, PY1, alY, l_reg, pa0, pa1, pa2, pa3); SBAR();                                                           \
        if ((t) + 1 < NT) { SLOAD_H(Kh, Vh, KBASE((t) + 1)); SBAR(); }                                                        \
        pv_tile<VB>(o, vb0, pa0, pa1, pa2, pa3); MASKT(PX0, PX1, (t)); partialSM(PX0, PX1, m_reg, mnX, alX);                  \
        __syncthreads();                                                                                                      \
        if ((t) + 1 < NT) { VMW(); SWRITE_H(SB); }                                                                            \
        RESC(alX); __syncthreads(); } while (0)
    for (int t = 1; t + 1 < NT; t += 2) {
        HALF_STEP(pB0, pB1, mnB, alB, pA0, pA1, alA, t, 1, 0, 0);
        HALF_STEP(pA0, pA1, mnA, alA, pB0, pB1, alB, t + 1, 0, 1, 1);
    }
    const bool even = (NT & 1) == 0;
    if (even) { SBAR(); qkt<1>(pB0, pB1, K_lds, r32, hi, kmp, S.qr); SBAR(); }
    SLOAD_H(nxt.K, nxt.V, 0); SBAR();
#pragma unroll
    for (int dd = 0; dd < 4; ++dd) S.qr[dd] = load8(nxt.Q + (size_t)(wq * QBLK + r32) * LDQ + mp * 64 + dd * 16 + hi * 8);
    SBAR();
    finishSM(pA0, pA1, alA, l_reg, pa0, pa1, pa2, pa3); SBAR();
    pv_tile<0>(o, vb0, pa0, pa1, pa2, pa3);
    if (even) { MASKT(pB0, pB1, NT - 1); partialSM(pB0, pB1, m_reg, mnB, alB); __syncthreads(); RESC(alB);
        finishSM(pB0, pB1, alB, l_reg, pa0, pa1, pa2, pa3); SBAR(); pv_tile<1>(o, vb0, pa0, pa1, pa2, pa3); }
    SBAR(); SEAM_K0();
    if (hi == 0) li_l[r32] = l_reg; asm volatile("s_waitcnt lgkmcnt(0)" ::: "memory");
    float rli[16];
#pragma unroll
    for (int r = 0; r < 16; ++r) rli[r] = __builtin_amdgcn_rcpf(li_l[crow(r, hi)]);
    float* xch = (float*)(lds + LDS_XCH) + wq * 4096 + lane;
    if (mp == 1) {
#pragma unroll
        for (int d0 = 0; d0 < 4; ++d0)
#pragma unroll
            for (int r = 0; r < 16; ++r) xch[(d0 * 16 + r) * 64] = o[d0][r] * rli[r] * lam;
    }
    __syncthreads();
    if (mp == 0) {
        float ss[16];
#pragma unroll
        for (int r = 0; r < 16; ++r) ss[r] = 0.f;
#pragma unroll
        for (int d0 = 0; d0 < 4; ++d0)
#pragma unroll
            for (int r = 0; r < 16; ++r) { const float v = o[d0][r] * rli[r] - xch[(d0 * 16 + r) * 64]; o[d0][r] = v; ss[r] = fmaf(v, v, ss[r]); }
#pragma unroll
        for (int r = 0; r < 16; ++r) { float s = ss[r]; s += __shfl_xor(s, 1); s += __shfl_xor(s, 2); s += __shfl_xor(s, 4); s += __shfl_xor(s, 8); s += __shfl_xor(s, 16);
            ss[r] = 0.8f / sqrtf(s * (1.0f / 128.0f) + 1e-6f); }
        float sg[4];
#pragma unroll
        for (int d0 = 0; d0 < 4; ++d0) sg[d0] = subln[d0 * 32 + r32];
#pragma unroll
        for (int r = 0; r < 16; ++r) { const int orow = wq * QBLK + crow(r, hi);
#pragma unroll
            for (int d0 = 0; d0 < 4; ++d0) { const int col = d0 * 32 + r32;
                const float g = __uint_as_float((unsigned)cur.GA[(size_t)orow * LDQ + col] << 16);
                const float v = o[d0][r] * ss[r] * sg[d0] * g; const float vn = __shfl_xor(v, 1);
                if ((r32 & 1) == 0) *(unsigned*)(cur.O + (size_t)orow * LDO + col) = cvtpk(v, vn); } }
    }
    __syncthreads();
#undef RESC
#undef KBASE
#undef MASKT
#undef SEAM_K0
#undef HALF_STEP
}
#undef ROW
#undef VMW
#undef VMWN
#undef SLOAD_H
#undef SWRITE_HK
#undef SWRITE_HV
#undef SWRITE_H
#undef KSWZ
#undef SBAR
__device__ __forceinline__ void attn_phase(char* lds, const bf16* Q, const bf16* K, const bf16* V, const bf16* GA, bf16* mix, float lam, const float* subln) {
    for (int it = blockIdx.x; it < 256; it += gridDim.x) {
        const int xcd = it & 7, k = it >> 3, bh = xcd * 4 + (k >> 3), x = k & 7, b = bh >> 3, h = bh & 7;
        const size_t base = (size_t)b * 2048 * LDQ + h * 128;
        BlockRef r0, r1;
        r0.P0 = 128 * x; r1.P0 = 128 * (15 - x);
        r0.K = r1.K = K + base; r0.V = r1.V = V + base;
        r0.Q = Q + base + (size_t)r0.P0 * LDQ; r1.Q = Q + base + (size_t)r1.P0 * LDQ;
        r0.GA = GA + base + (size_t)r0.P0 * LDQ; r1.GA = GA + base + (size_t)r1.P0 * LDQ;
        r0.O = mix + ((size_t)b * 2048 + r0.P0) * LDO + h * 128; r1.O = mix + ((size_t)b * 2048 + r1.P0) * LDO + h * 128;
        Seam S;
        attn_prime(r0, lds, S);
        attn_block(r0, r1, lam, subln, lds, S);
        attn_block(r1, r1, lam, subln, lds, S);
    }
}
}

namespace rgl {
typedef short bf16x8 __attribute__((ext_vector_type(8)));
typedef short s16x4 __attribute__((ext_vector_type(4)));
typedef float f32x16 __attribute__((ext_vector_type(16)));
typedef unsigned short bf16;
constexpr int LDS_Y = 0, LDS_AGG = 65536, LDS_RGL_BYTES = LDS_AGG + 2 * 8 * 16 * 2 * 4;
constexpr float LOG2E = 1.4426950408889634f;
#define KSWZ(row, colB) ((row) * 256 + ((colB) ^ (((row) & 7) << 4)))
__device__ __forceinline__ float bf(short v) { return __uint_as_float(((unsigned)(unsigned short)v) << 16); }
__device__ __forceinline__ unsigned cvtpk(float lo, float hi) { unsigned r; asm volatile("v_cvt_pk_bf16_f32 %0, %1, %2" : "=v"(r) : "v"(lo), "v"(hi)); return r; }
__device__ __forceinline__ int crow(int r, int hi) { return (r & 3) + 8 * (r >> 2) + 4 * hi; }
__device__ __forceinline__ void rglru_slice(char* lds, int b, int n, int cs, const bf16* XR, const bf16* GR, const bf16* WgT, const float* cw, const float* cb,
                                            const float* ba, const float* bx, const float* lam, bf16* mix) {
    const int tid = threadIdx.x, wid = __builtin_amdgcn_readfirstlane(tid >> 6), lane = tid & 63, t32 = lane & 31, hi = lane >> 5;
    char* ytile = lds + LDS_Y; float* agg = (float*)(lds + LDS_AGG);
    bf16x8 af[8];
    { const bf16* wrow = WgT + ((size_t)(n * 2 + (t32 >> 4)) * 128 + cs * 16 + (t32 & 15)) * 128 + 8 * hi;
#pragma unroll
      for (int kk = 0; kk < 8; ++kk) af[kk] = *reinterpret_cast<const bf16x8*>(wrow + 16 * kk); }
    float bav[8], bxv[8], nsp[8];
#pragma unroll
    for (int r = 0; r < 8; ++r) { const int c = n * 128 + cs * 16 + crow(r, hi); bav[r] = ba[c]; bxv[r] = bx[c];
        const float L = lam[c]; const float sp = (-L > 20.f) ? -L : log1pf(expf(-L)); nsp[r] = -8.0f * sp; }
    const int cg = tid & 15, rg = tid >> 4;
    float cwv[4][8], cbv[8];
#pragma unroll
    for (int e = 0; e < 8; ++e) { const int c = n * 128 + 8 * cg + e; cbv[e] = cb[c];
#pragma unroll
        for (int j = 0; j < 4; ++j) cwv[j][e] = cw[j * 1024 + c]; }
    const bf16* xcol = XR + (size_t)b * 2048 * 1024 + n * 128 + 8 * cg;
    float carry = 0.f;
    for (int ch = 0; ch < 8; ++ch) {
        const int t0 = ch * 256, tr = t0 + 8 * rg;
        bf16x8 xv[11];
#pragma unroll
        for (int i = 0; i < 11; ++i) { const int t = tr - 3 + i; xv[i] = (t >= 0) ? *reinterpret_cast<const bf16x8*>(xcol + (size_t)t * 1024) : (bf16x8){0, 0, 0, 0, 0, 0, 0, 0}; }
#pragma unroll
        for (int i = 0; i < 8; ++i) {
            float y[8];
#pragma unroll
            for (int e = 0; e < 8; ++e) { float a = cbv[e];
#pragma unroll
                for (int j = 0; j < 4; ++j) a = fmaf(cwv[j][e], bf(xv[i + j][e]), a);
                y[e] = a; }
            unsigned w0 = cvtpk(y[0], y[1]), w1 = cvtpk(y[2], y[3]), w2 = cvtpk(y[4], y[5]), w3 = cvtpk(y[6], y[7]);
            typedef unsigned u32x4 __attribute__((ext_vector_type(4)));
            *reinterpret_cast<u32x4*>(ytile + KSWZ(8 * rg + i, cg * 16)) = (u32x4){w0, w1, w2, w3};
        }
        __syncthreads();
        const int trow = 32 * wid + t32;
        f32x16 acc = {};
#pragma unroll
        for (int kk = 0; kk < 8; ++kk) { const bf16x8 bfrag = *reinterpret_cast<const bf16x8*>(ytile + KSWZ(trow, (16 * kk + 8 * hi) * 2));
            acc = __builtin_amdgcn_mfma_f32_32x32x16_bf16(af[kk], bfrag, acc, 0, 0, 0); }
        float av[8], uv[8];
#pragma unroll
        for (int g = 0; g < 2; ++g) {
            const s16x4 y4 = *reinterpret_cast<const s16x4*>(ytile + KSWZ(trow, (cs * 16 + 8 * g + 4 * hi) * 2));
#pragma unroll
            for (int e = 0; e < 4; ++e) { const int r = 4 * g + e;
                const float rgate = __builtin_amdgcn_rcpf(1.0f + __builtin_amdgcn_exp2f(-LOG2E * (acc[r] + bav[r])));
                const float igate = __builtin_amdgcn_rcpf(1.0f + __builtin_amdgcn_exp2f(-LOG2E * (acc[r + 8] + bxv[r])));
                const float log_a = rgate * nsp[r];
                const float a = __builtin_amdgcn_exp2f(LOG2E * log_a);
                const float x2 = 2.0f * log_a;
                float q = fmaf(x2, 1.0f / 720.0f, 1.0f / 120.0f); q = fmaf(q, x2, 1.0f / 24.0f); q = fmaf(q, x2, 1.0f / 6.0f); q = fmaf(q, x2, 0.5f); q = fmaf(q, x2, 1.0f);
                const float em_small = -x2 * q;
                const float em = (x2 > -0.25f) ? em_small : (1.0f - a * a);
                av[r] = a; uv[r] = sqrtf(em) * (igate * bf(y4[e])); }
        }
#pragma unroll
        for (int d = 1; d < 32; d <<= 1) {
#pragma unroll
            for (int r = 0; r < 8; ++r) { const float ap = __shfl_up(av[r], d, 32), up = __shfl_up(uv[r], d, 32);
                if (t32 >= d) { uv[r] = fmaf(av[r], up, uv[r]); av[r] = av[r] * ap; } }
        }
        float* ag = agg + (ch & 1) * 256;
        if (t32 == 31) {
#pragma unroll
            for (int r = 0; r < 8; ++r) { ag[(wid * 16 + crow(r, hi)) * 2] = av[r]; ag[(wid * 16 + crow(r, hi)) * 2 + 1] = uv[r]; } }
        __syncthreads();
        float hin = 0.f;
        { const int c16 = lane & 15; float h = carry; float A[8], H[8];
#pragma unroll
          for (int w = 0; w < 8; ++w) { A[w] = ag[(w * 16 + c16) * 2]; H[w] = ag[(w * 16 + c16) * 2 + 1]; }
#pragma unroll
          for (int w = 0; w < 8; ++w) { if (w == wid) hin = h; h = fmaf(A[w], h, H[w]); }
          carry = h; }
        const size_t row = (size_t)b * 2048 + t0 + trow;
#pragma unroll
        for (int g = 0; g < 2; ++g) {
            const int c0 = n * 128 + cs * 16 + 8 * g + 4 * hi;
            const s16x4 g4 = *reinterpret_cast<const s16x4*>(GR + row * 1024 + c0);
            float hv[4];
#pragma unroll
            for (int e = 0; e < 4; ++e) { const int r = 4 * g + e; const float hs = __shfl(hin, crow(r, hi)); hv[e] = fmaf(av[r], hs, uv[r]) * bf(g4[e]); }
            typedef unsigned u32x2 __attribute__((ext_vector_type(2)));
            *reinterpret_cast<u32x2*>(mix + row * 2048 + 1024 + c0) = (u32x2){cvtpk(hv[0], hv[1]), cvtpk(hv[2], hv[3])};
        }
    }
    __syncthreads();
}
#undef KSWZ
__device__ __forceinline__ void rglru_phase(char* lds, const bf16* XR, const bf16* GR, const bf16* WgT, const float* cw, const float* cb, const float* ba, const float* bx, const float* lam, bf16* mix) {
    for (int it = blockIdx.x; it < 256; it += gridDim.x) {
        const int xcd = it & 7, k = it >> 3, bn = xcd * 4 + (k >> 3), cs = k & 7;
        rglru_slice(lds, bn >> 3, bn & 7, cs, XR, GR, WgT, cw, cb, ba, bx, lam, mix);
    }
}
}

__device__ __forceinline__ float bf2f(bf16 v) { return __uint_as_float((unsigned)v << 16); }
__device__ __forceinline__ unsigned f2bf(float f) { unsigned u = __builtin_bit_cast(unsigned, f); return (u + 0x7fffu + ((u >> 16) & 1u)) >> 16; }
__device__ __forceinline__ unsigned pk2(float lo, float hi) { return f2bf(lo) | (f2bf(hi) << 16); }
#define LDS_WAIT() asm volatile("s_waitcnt lgkmcnt(0)" ::: "memory")

__device__ __forceinline__ float silu_f(float x) { return x / (1.0f + expf(-x)); }
__device__ __forceinline__ float sigmoid_f(float x) { return 1.0f / (1.0f + expf(-x)); }

__device__ __forceinline__ float block_sum(float v, float* red) {
    for (int o = 32; o > 0; o >>= 1) v += __shfl_xor(v, o);
    const int w = threadIdx.x >> 6, l = threadIdx.x & 63;
    __syncthreads();
    if (l == 0) red[w] = v;
    __syncthreads();
    float t = 0.f;
#pragma unroll
    for (int i = 0; i < 8; ++i) t += red[i];
    return t;
}

__device__ void nv_rmsnorm(float* lds, const float* a, const float* b, const float* g, float* out) {
    float* red = lds;
    for (int row = blockIdx.x; row < M; row += gridDim.x) {
        float v[4]; float s = 0.f;
#pragma unroll
        for (int i = 0; i < 4; ++i) { const int c = threadIdx.x + NT * i; float x = a[(size_t)row * DM + c]; if (b) x += b[(size_t)row * DM + c]; v[i] = x; s += x * x; }
        const float tot = block_sum(s, red);
        const float rs = 1.0f / sqrtf(tot / DM + EPS);
#pragma unroll
        for (int i = 0; i < 4; ++i) { const int c = threadIdx.x + NT * i; out[(size_t)row * DM + c] = v[i] * rs * g[c]; }
    }
}
__device__ void nv_gemm(float* lds, const float* A, const float* B, float* C, int Mm, int Nn, int Kk) {
    float (*As)[132] = (float (*)[132])lds;
    float (*Bs)[68] = (float (*)[68])(lds + 16 * 132);
    const int tx = threadIdx.x & 15, ty = threadIdx.x >> 4;
    const int ntn = Nn / 64, ntiles = (Mm / 128) * ntn;
    for (int t = blockIdx.x; t < ntiles; t += gridDim.x) {
        const int m0 = (t / ntn) * 128, n0 = (t % ntn) * 64;
        float acc[4][4] = {};
        for (int k0 = 0; k0 < Kk; k0 += 16) {
            {
                const int r = threadIdx.x >> 2, kk = (threadIdx.x & 3) * 4;
                const float4 a = *(const float4*)(A + (size_t)(m0 + r) * Kk + k0 + kk);
                As[kk + 0][r] = a.x; As[kk + 1][r] = a.y; As[kk + 2][r] = a.z; As[kk + 3][r] = a.w;
                if (threadIdx.x < 256) { const int kr = threadIdx.x >> 4, nn = (threadIdx.x & 15) * 4;
                    *(float4*)&Bs[kr][nn] = *(const float4*)(B + (size_t)(k0 + kr) * Nn + n0 + nn); }
            }
            __syncthreads();
#pragma unroll
            for (int k = 0; k < 16; ++k) {
                const float4 a = *(const float4*)&As[k][ty * 4];
                const float4 b = *(const float4*)&Bs[k][tx * 4];
                const float av[4] = {a.x, a.y, a.z, a.w}, bv[4] = {b.x, b.y, b.z, b.w};
#pragma unroll
                for (int i = 0; i < 4; ++i)
#pragma unroll
                    for (int j = 0; j < 4; ++j) acc[i][j] = fmaf(av[i], bv[j], acc[i][j]);
            }
            __syncthreads();
        }
#pragma unroll
        for (int i = 0; i < 4; ++i) *(float4*)(C + (size_t)(m0 + ty * 4 + i) * Nn + n0 + tx * 4) = make_float4(acc[i][0], acc[i][1], acc[i][2], acc[i][3]);
    }
}
__device__ void nv_rope(float* proj, const int* pos) {
    for (int row = blockIdx.x; row < M; row += gridDim.x) {
        const float p = (float)pos[row];
        for (int i = threadIdx.x; i < 1024; i += NT) {
            const int j = i & 31, grp = i >> 5;
            const float inv_freq = powf(10000.0f, -(float)(2 * j) / 64.0f);
            const float ang = p * inv_freq;
            const float c = cosf(ang), s = sinf(ang);
            float* base = proj + (size_t)row * INW + grp * 64;
            const float t1 = base[j], t2 = base[j + 32];
            base[j] = t1 * c - t2 * s; base[j + 32] = t2 * c + t1 * s;
        }
    }
}
__device__ void nv_attn(float* lds, const float* proj, const float* lq1, const float* lk1, const float* lq2, const float* lk2, const float* subln, float* mix) {
    const int wid = threadIdx.x >> 6, lane = threadIdx.x & 63;
    float* ps0 = lds + wid * 256; float* ps1 = ps0 + 64; float* qs = ps0 + 128;
    float a1 = lq1[lane] * lk1[lane], a2 = lq2[lane] * lk2[lane];
    for (int o = 32; o > 0; o >>= 1) { a1 += __shfl_xor(a1, o); a2 += __shfl_xor(a2, o); }
    const float lam_init = 0.8f - 0.6f * expf(-0.3f * 0.0f);
    const float lam = expf(a1) - expf(a2) + lam_init;
    const float scale = 0.125f;
    for (int task = blockIdx.x * 8 + wid; task < M * NH; task += gridDim.x * 8) {
        const int row = task / NH, h = task % NH;
        const int b = row / SEQ, s = row % SEQ;
        const float* qrow = proj + (size_t)row * INW + C_Q + h * 128;
        __builtin_amdgcn_wave_barrier();
        qs[lane] = qrow[lane]; qs[64 + lane] = qrow[64 + lane];
        __builtin_amdgcn_wave_barrier();
        const float* q0 = qs; const float* q1 = qs + 64;
        float m0 = -INFINITY, m1 = -INFINITY;
        for (int k0 = 0; k0 <= s; k0 += 64) {
            const int k = k0 + lane;
            if (k <= s) {
                const float* krow = proj + (size_t)(b * SEQ + k) * INW + C_K + h * 128;
                float s0 = 0.f, s1 = 0.f;
                for (int d = 0; d < 64; d += 4) { const float4 ka = *(const float4*)(krow + d), kb = *(const float4*)(krow + 64 + d);
                    s0 = fmaf(q0[d], ka.x, s0); s0 = fmaf(q0[d + 1], ka.y, s0); s0 = fmaf(q0[d + 2], ka.z, s0); s0 = fmaf(q0[d + 3], ka.w, s0);
                    s1 = fmaf(q1[d], kb.x, s1); s1 = fmaf(q1[d + 1], kb.y, s1); s1 = fmaf(q1[d + 2], kb.z, s1); s1 = fmaf(q1[d + 3], kb.w, s1); }
                m0 = fmaxf(m0, s0 * scale); m1 = fmaxf(m1, s1 * scale);
            }
        }
        for (int o = 32; o > 0; o >>= 1) { m0 = fmaxf(m0, __shfl_xor(m0, o)); m1 = fmaxf(m1, __shfl_xor(m1, o)); }
        float l0 = 0.f, l1 = 0.f, o0a = 0.f, o0b = 0.f, o1a = 0.f, o1b = 0.f;
        for (int k0 = 0; k0 <= s; k0 += 64) {
            const int k = k0 + lane;
            float p0 = 0.f, p1 = 0.f;
            if (k <= s) {
                const float* krow = proj + (size_t)(b * SEQ + k) * INW + C_K + h * 128;
                float s0 = 0.f, s1 = 0.f;
                for (int d = 0; d < 64; d += 4) { const float4 ka = *(const float4*)(krow + d), kb = *(const float4*)(krow + 64 + d);
                    s0 = fmaf(q0[d], ka.x, s0); s0 = fmaf(q0[d + 1], ka.y, s0); s0 = fmaf(q0[d + 2], ka.z, s0); s0 = fmaf(q0[d + 3], ka.w, s0);
                    s1 = fmaf(q1[d], kb.x, s1); s1 = fmaf(q1[d + 1], kb.y, s1); s1 = fmaf(q1[d + 2], kb.z, s1); s1 = fmaf(q1[d + 3], kb.w, s1); }
                p0 = expf(s0 * scale - m0); p1 = expf(s1 * scale - m1);
            }
            l0 += p0; l1 += p1;
            __builtin_amdgcn_wave_barrier();
            ps0[lane] = p0; ps1[lane] = p1;
            __builtin_amdgcn_wave_barrier();
            const int kmax = (s - k0 + 1) < 64 ? (s - k0 + 1) : 64;
            for (int j = 0; j < kmax; ++j) {
                const float* vrow = proj + (size_t)(b * SEQ + k0 + j) * INW + C_V + h * 128;
                const float va = vrow[lane], vb = vrow[64 + lane];
                const float w0 = ps0[j], w1 = ps1[j];
                o0a = fmaf(w0, va, o0a); o0b = fmaf(w0, vb, o0b); o1a = fmaf(w1, va, o1a); o1b = fmaf(w1, vb, o1b);
            }
        }
        for (int o = 32; o > 0; o >>= 1) { l0 += __shfl_xor(l0, o); l1 += __shfl_xor(l1, o); }
        const float oa = o0a / l0 - lam * (o1a / l1), ob = o0b / l0 - lam * (o1b / l1);
        float ss = oa * oa + ob * ob;
        for (int o = 32; o > 0; o >>= 1) ss += __shfl_xor(ss, o);
        const float rs = 1.0f / sqrtf(ss / 128.0f + EPS);
        const float* grow = proj + (size_t)row * INW + C_GA + h * 128;
        float* mrow = mix + (size_t)row * (AW + RW) + h * 128;
        mrow[lane] = oa * rs * subln[lane] * (1.0f - lam_init) * silu_f(grow[lane]);
        mrow[64 + lane] = ob * rs * subln[64 + lane] * (1.0f - lam_init) * silu_f(grow[64 + lane]);
    }
}
__device__ void nv_conv(const float* proj, const float* cw, const float* cb, float* y) {
    for (int row = blockIdx.x; row < M; row += gridDim.x) {
        const int s = row % SEQ;
        for (int c = threadIdx.x; c < RW; c += NT) {
            float acc = cb[c];
            for (int j = 0; j < CW; ++j) { const int t = s - 3 + j; if (t >= 0) acc = fmaf(cw[j * RW + c], proj[(size_t)(row - 3 + j) * INW + C_XR + c], acc); }
            y[(size_t)row * RW + c] = acc;
        }
    }
}
__device__ void nv_gates(float* lds, const float* y, const float* wa, const float* ba, const float* wx, const float* bx, const float* lam, float* aout, float* uout) {
    float* ys = lds;
    for (int row = blockIdx.x; row < M; row += gridDim.x) {
        __syncthreads();
        for (int c = threadIdx.x; c < RW; c += NT) ys[c] = y[(size_t)row * RW + c];
        __syncthreads();
        for (int c = threadIdx.x; c < RW; c += NT) {
            const int n = c / RB, j = c % RB;
            float ga = 0.f, gx = 0.f;
            for (int i = 0; i < RB; ++i) { const float yi = ys[n * RB + i]; ga = fmaf(yi, wa[((size_t)n * RB + i) * RB + j], ga); gx = fmaf(yi, wx[((size_t)n * RB + i) * RB + j], gx); }
            const float r = sigmoid_f(ga + ba[c]), ig = sigmoid_f(gx + bx[c]);
            const float L = lam[c];
            const float sp = (-L > 20.f) ? -L : log1pf(expf(-L));
            const float log_a = -LRU_C * r * sp;
            const float a = expf(log_a);
            const float mult = sqrtf(-expm1f(2.0f * log_a));
            aout[(size_t)row * RW + c] = a;
            uout[(size_t)row * RW + c] = mult * (ig * ys[c]);
        }
    }
}
__device__ void nv_scan(const float* a, const float* u, const float* proj, float* mix) {
    for (int idx = blockIdx.x * NT + threadIdx.x; idx < BATCH * RW; idx += gridDim.x * NT) {
        const int b = idx / RW, c = idx % RW;
        float h = 0.f;
        for (int s = 0; s < SEQ; ++s) {
            const size_t row = (size_t)b * SEQ + s;
            h = fmaf(a[row * RW + c], h, u[row * RW + c]);
            mix[row * (AW + RW) + AW + c] = h * silu_f(proj[row * INW + C_GR + c]);
        }
    }
}


__device__ void nv_attn_bf(float* lds, const bf16* Q, const bf16* K, const bf16* V, const bf16* GA, const float* lq1, const float* lk1, const float* lq2, const float* lk2, const float* subln, bf16* mix) {
    const int wid = threadIdx.x >> 6, lane = threadIdx.x & 63;
    float* ps0 = lds + wid * 256; float* ps1 = ps0 + 64; float* qs = ps0 + 128;
    float a1 = lq1[lane] * lk1[lane], a2 = lq2[lane] * lk2[lane];
    for (int o = 32; o > 0; o >>= 1) { a1 += __shfl_xor(a1, o); a2 += __shfl_xor(a2, o); }
    const float lam_init = 0.8f - 0.6f * expf(-0.3f * 0.0f);
    const float lam = expf(a1) - expf(a2) + lam_init;
    for (int task = blockIdx.x * 8 + wid; task < M * NH; task += gridDim.x * 8) {
        const int row = task / NH, h = task % NH;
        const int b = row / SEQ, s = row % SEQ;
        const bf16* qrow = Q + (size_t)row * 1024 + h * 128;
        __builtin_amdgcn_wave_barrier();
        qs[lane] = bf2f(qrow[lane]); qs[64 + lane] = bf2f(qrow[64 + lane]);
        __builtin_amdgcn_wave_barrier();
        const float* q0 = qs; const float* q1 = qs + 64;
        float m0 = -INFINITY, m1 = -INFINITY;
        for (int k0 = 0; k0 <= s; k0 += 64) {
            const int k = k0 + lane;
            if (k <= s) {
                const bf16* krow = K + (size_t)(b * SEQ + k) * 1024 + h * 128;
                float s0 = 0.f, s1 = 0.f;
                for (int d = 0; d < 64; ++d) { s0 = fmaf(q0[d], bf2f(krow[d]), s0); s1 = fmaf(q1[d], bf2f(krow[64 + d]), s1); }
                m0 = fmaxf(m0, s0); m1 = fmaxf(m1, s1);
            }
        }
        for (int o = 32; o > 0; o >>= 1) { m0 = fmaxf(m0, __shfl_xor(m0, o)); m1 = fmaxf(m1, __shfl_xor(m1, o)); }
        float l0 = 0.f, l1 = 0.f, o0a = 0.f, o0b = 0.f, o1a = 0.f, o1b = 0.f;
        for (int k0 = 0; k0 <= s; k0 += 64) {
            const int k = k0 + lane;
            float p0 = 0.f, p1 = 0.f;
            if (k <= s) {
                const bf16* krow = K + (size_t)(b * SEQ + k) * 1024 + h * 128;
                float s0 = 0.f, s1 = 0.f;
                for (int d = 0; d < 64; ++d) { s0 = fmaf(q0[d], bf2f(krow[d]), s0); s1 = fmaf(q1[d], bf2f(krow[64 + d]), s1); }
                p0 = expf(s0 - m0); p1 = expf(s1 - m1);
            }
            l0 += p0; l1 += p1;
            __builtin_amdgcn_wave_barrier();
            ps0[lane] = p0; ps1[lane] = p1;
            __builtin_amdgcn_wave_barrier();
            const int kmax = (s - k0 + 1) < 64 ? (s - k0 + 1) : 64;
            for (int j = 0; j < kmax; ++j) {
                const bf16* vrow = V + (size_t)(b * SEQ + k0 + j) * 1024 + h * 128;
                const float va = bf2f(vrow[lane]), vb = bf2f(vrow[64 + lane]);
                const float w0 = ps0[j], w1 = ps1[j];
                o0a = fmaf(w0, va, o0a); o0b = fmaf(w0, vb, o0b); o1a = fmaf(w1, va, o1a); o1b = fmaf(w1, vb, o1b);
            }
        }
        for (int o = 32; o > 0; o >>= 1) { l0 += __shfl_xor(l0, o); l1 += __shfl_xor(l1, o); }
        const float oa = o0a / l0 - lam * (o1a / l1), ob = o0b / l0 - lam * (o1b / l1);
        float ss = oa * oa + ob * ob;
        for (int o = 32; o > 0; o >>= 1) ss += __shfl_xor(ss, o);
        const float rs = 1.0f / sqrtf(ss / 128.0f + EPS);
        const bf16* grow = GA + (size_t)row * 1024 + h * 128;
        bf16* mrow = mix + (size_t)row * (AW + RW) + h * 128;
        mrow[lane] = (bf16)f2bf(oa * rs * subln[lane] * (1.0f - lam_init) * bf2f(grow[lane]));
        mrow[64 + lane] = (bf16)f2bf(ob * rs * subln[64 + lane] * (1.0f - lam_init) * bf2f(grow[64 + lane]));
    }
}
__device__ void nv_conv_bf(const bf16* XR, const float* cw, const float* cb, float* y) {
    for (int row = blockIdx.x; row < M; row += gridDim.x) {
        const int s = row % SEQ;
        for (int c = threadIdx.x; c < RW; c += NT) {
            float acc = cb[c];
            for (int j = 0; j < CW; ++j) { const int t = s - 3 + j; if (t >= 0) acc = fmaf(cw[j * RW + c], bf2f(XR[(size_t)(row - 3 + j) * 1024 + c]), acc); }
            y[(size_t)row * RW + c] = acc;
        }
    }
}
__device__ void nv_scan_bf(const float* a, const float* u, const bf16* GR, bf16* mix) {
    for (int idx = blockIdx.x * NT + threadIdx.x; idx < BATCH * RW; idx += gridDim.x * NT) {
        const int b = idx / RW, c = idx % RW;
        float h = 0.f;
        for (int s = 0; s < SEQ; ++s) {
            const size_t row = (size_t)b * SEQ + s;
            h = fmaf(a[row * RW + c], h, u[row * RW + c]);
            mix[row * (AW + RW) + AW + c] = (bf16)f2bf(h * bf2f(GR[row * 1024 + c]));
        }
    }
}

__device__ __forceinline__ float wave_sum(float v) {
#pragma unroll
    for (int o = 1; o < 64; o <<= 1) v += __shfl_xor(v, o);
    return v;
}
__device__ __forceinline__ void p0_transpose_item(const float* W, int K, int N, bf16* WT, int perm_rows, LAS float* scr, int item, int lane) {
    const int nblk = N / 32, kb = item / nblk, nb = item % nblk, k0 = 64 * kb, n0 = 32 * nb;
    const int np = n0 + (lane & 31);
    const int nsrc = np < perm_rows ? ((np & ~63) + ((np & 63) >> 1) + 32 * (np & 1)) : np;
#pragma unroll 8
    for (int i = 0; i < 32; ++i) { const int kk = 2 * i + (lane >> 5); scr[kk * 33 + (lane & 31)] = W[(size_t)(k0 + kk) * N + nsrc]; }
    LDS_WAIT(); asm volatile("" ::: "memory");
    const int c = lane & 7;
#pragma unroll
    for (int j = 0; j < 4; ++j) { const int n = (lane >> 3) + 8 * j; const LAS float* s = scr + (8 * c) * 33 + n;
        v4u o; o.x = pk2(s[0 * 33], s[1 * 33]); o.y = pk2(s[2 * 33], s[3 * 33]); o.z = pk2(s[4 * 33], s[5 * 33]); o.w = pk2(s[6 * 33], s[7 * 33]);
        *(GAS v4u*)(WT + (size_t)(n0 + n) * K + k0 + 8 * c) = o; }
    LDS_WAIT(); asm volatile("" ::: "memory");
}
__device__ __forceinline__ void rms_row_to_bf16(const float* xrow, const float* g, bf16* orow, int lane) {
    typedef float f32x4 __attribute__((ext_vector_type(4)));
    const GAS f32x4* xr = (const GAS f32x4*)xrow + lane; const GAS f32x4* gr = (const GAS f32x4*)g + lane;
    f32x4 v[8]; float s = 0.f;
#pragma unroll
    for (int j = 0; j < 8; ++j) { v[j] = xr[64 * j]; s += (v[j].x * v[j].x + v[j].y * v[j].y) + (v[j].z * v[j].z + v[j].w * v[j].w); }
    const float rstd = 1.f / sqrtf(wave_sum(s) * (1.f / DM) + EPS);
    GAS unsigned long long* o8 = (GAS unsigned long long*)orow + lane;
#pragma unroll
    for (int j = 0; j < 8; ++j) { const f32x4 gg = gr[64 * j];
        o8[64 * j] = (unsigned long long)pk2(v[j].x * rstd * gg.x, v[j].y * rstd * gg.y) | ((unsigned long long)pk2(v[j].z * rstd * gg.z, v[j].w * rstd * gg.w) << 32); }
}

struct Args { const void* in[18]; float* out; unsigned char* ws; };

__global__ void __launch_bounds__(NT, 2) fwd_mega(Args args) {
    extern __shared__ __attribute__((aligned(16))) unsigned char lds_raw[];
    float* lds = (float*)lds_raw;
    cg::grid_group grid = cg::this_grid();
    const float* x = (const float*)args.in[0]; const int* pos = (const int*)args.in[1]; const float* ng = (const float*)args.in[2]; const float* w_in = (const float*)args.in[3];
    const float* lq1 = (const float*)args.in[4]; const float* lk1 = (const float*)args.in[5]; const float* lq2 = (const float*)args.in[6]; const float* lk2 = (const float*)args.in[7];
    const float* subln = (const float*)args.in[8]; const float* cw = (const float*)args.in[9]; const float* cb = (const float*)args.in[10];
    const float* wa = (const float*)args.in[11]; const float* ba = (const float*)args.in[12]; const float* wx = (const float*)args.in[13]; const float* bx = (const float*)args.in[14];
    const float* lam = (const float*)args.in[15]; const float* w_out = (const float*)args.in[16]; const float* fg = (const float*)args.in[17];
    float* out = args.out; unsigned char* ws = args.ws;
    const int tid = threadIdx.x, lane = tid & 63, wave = __builtin_amdgcn_readfirstlane(tid >> 6);
    const int G = gridDim.x;
    bf16* Wt_in = (bf16*)(ws + WS_WIN); bf16* XN = (bf16*)(ws + WS_XN); float* rope = (float*)(ws + WS_ROPE);
    bf16* Qb = (bf16*)(ws + WS_Q); bf16* Kb = (bf16*)(ws + WS_K); bf16* Vb = (bf16*)(ws + WS_V); bf16* GAb = (bf16*)(ws + WS_GA); bf16* XRb = (bf16*)(ws + WS_XR); bf16* GRb = (bf16*)(ws + WS_GR);
    bf16* WgT = (bf16*)(ws + WS_WG);
    bf16* mix = (bf16*)(ws + WS_MIX); bf16* Wt_out = (bf16*)(ws + WS_WOUT); float* part = (float*)(ws + WS_PART);

    {
        LAS float* scr = (LAS float*)((LAS unsigned char*)lds_raw + wave * 16384);
        const int gw = blockIdx.x * NWAVES + wave, NGW = G * NWAVES;
        constexpr int I_IN = (DM / 64) * (INW / 32);
        for (int it = gw; it < I_IN; it += NGW) p0_transpose_item(w_in, DM, INW, Wt_in, 2048, scr, it, lane);
        constexpr int I_OUT = (DM / 64) * (DM / 32);
        for (int it = gw; it < I_OUT; it += NGW) p0_transpose_item(w_out, DM, DM, Wt_out, 0, scr, it, lane);
        for (int idx = gw * 64 + lane; idx < NRB * 2 * RB * RB; idx += NGW * 64) {
            const int i = idx & 127, j = (idx >> 7) & 127, gate = (idx >> 14) & 1, n = idx >> 15;
            WgT[idx] = (bf16)f2bf((gate ? wx : wa)[((size_t)n * RB + i) * RB + j]);
        }
        for (int m = gw; m < M; m += NGW) rms_row_to_bf16(x + (size_t)m * DM, ng, XN + (size_t)m * DM, lane);
        for (int idx = gw * 64 + lane; idx < M * 32; idx += NGW * 64) {
            const int row = idx >> 5, j = idx & 31;
            const float inv_freq = powf(10000.0f, -(float)(2 * j) / 64.0f);
            const float ang = (float)pos[row] * inv_freq;
            rope[2 * idx] = cosf(ang); rope[2 * idx + 1] = sinf(ang);
        }
    }
    grid.sync();
    {
        pg8::Gemm g{XN, Wt_in, M, INW, DM}; pg8::StaticOrder S; S.init(M, INW, G, (int)blockIdx.x);
        pg8::EpiProj E{Qb, rope};
        pg8::gemm_phase<pg8::EpiProj, pg8::StaticOrder, true, true>((LAS unsigned char*)lds_raw, g, S, E);
    }
    grid.sync();
    {
        float a1 = lq1[lane] * lk1[lane], a2 = lq2[lane] * lk2[lane];
        for (int o = 32; o > 0; o >>= 1) { a1 += __shfl_xor(a1, o); a2 += __shfl_xor(a2, o); }
        const float lamv = expf(a1) - expf(a2) + 0.2f;
        att::attn_phase((char*)lds_raw, Qb, Kb, Vb, GAb, mix, lamv, subln);
    }
    rgl::rglru_phase((char*)lds_raw, XRb, GRb, WgT, cw, cb, ba, bx, lam, mix);
    grid.sync();
    {
        pg8::Gemm g{mix, Wt_out, M, DM, AW + RW}; pg8::StaticOrder S; S.init(M, DM, G, (int)blockIdx.x);
        pg8::EpiOut E{x, out, part};
        pg8::gemm_phase<pg8::EpiOut, pg8::StaticOrder, false, true>((LAS unsigned char*)lds_raw, g, S, E);
    }
    grid.sync();
    {
        typedef float f32x4 __attribute__((ext_vector_type(4)));
        const int gw = blockIdx.x * NWAVES + wave, NGW = G * NWAVES;
        for (int m = gw; m < M; m += NGW) {
            float p = (lane < 32) ? part[(size_t)m * 32 + lane] : 0.f;
            const float rstd = 1.f / sqrtf(wave_sum(p) * (1.f / DM) + EPS);
            f32x4* o = (f32x4*)(out + (size_t)m * DM) + lane; const f32x4* gp = (const f32x4*)fg + lane;
#pragma unroll
            for (int j = 0; j < 8; ++j) { f32x4 v = o[64 * j]; const f32x4 gg = gp[64 * j]; v = v * rstd * gg; o[64 * j] = v; }
        }
    }
}

extern "C" void kernel_launch(void* const* d_in, const int* in_sizes, int n_in, void* d_out, int out_size, void* d_ws, size_t ws_size, hipStream_t stream) {
    static int grid_blocks = 0;
    if (!grid_blocks) {
        int dev = 0, cus = 0, per_cu = 0;
        (void)hipGetDevice(&dev);
        (void)hipDeviceGetAttribute(&cus, hipDeviceAttributeMultiprocessorCount, dev);
        (void)hipFuncSetAttribute((const void*)fwd_mega, hipFuncAttributeMaxDynamicSharedMemorySize, LDS_BYTES);
        (void)hipOccupancyMaxActiveBlocksPerMultiprocessor(&per_cu, (const void*)fwd_mega, NT, LDS_BYTES);
        if (per_cu < 1) { fprintf(stderr, "occupancy query says %d blocks per CU\n", per_cu); per_cu = 1; }
        grid_blocks = cus * 1;
        fprintf(stderr, "fwd_mega: cus %d per_cu %d grid %d\n", cus, per_cu, grid_blocks);
    }
    Args a{};
    for (int i = 0; i < 18; ++i) a.in[i] = d_in[i];
    a.out = (float*)d_out; a.ws = (unsigned char*)d_ws;
    void* kargs[] = {&a};
    hipError_t e = hipLaunchCooperativeKernel((const void*)fwd_mega, dim3(grid_blocks), dim3(NT), kargs, LDS_BYTES, stream);
    if (e != hipSuccess) fprintf(stderr, "cooperative launch failed: %s (grid %d)\n", hipGetErrorString(e), grid_blocks);
}
```
